# Optimizing an MI355X kernel written in HIP

```python
import math
import jax, jax.numpy as jnp
from jax import lax
import numpy as np


D_MODEL = 1024
BATCH = 4
SEQ = 4096
DEPTH = 1
DEC_BATCH = 4
DEC_SEQ = 8192
PAST_LEN = 128

D_MIX = D_MODEL
D_HYENA = D_MIX // 2
D_RET = D_MIX - D_HYENA
HYENA_ORDER = 2
N_RET_HEADS = 4
RET_HEAD_DIM = D_RET // N_RET_HEADS
RET_CHUNK = 128
D_FF = 2816
FILT_EMB = 33
FILT_BANDS = (FILT_EMB - 1) // 2
FILT_HIDDEN = 64
ROPE_BASE = 10000.0
NORM_EPS = 1e-6
HYENA_TARGET = 1e-2
FAST_DECAY_PCT = 0.3
SLOW_DECAY_PCT = 1.5
D_IN = (HYENA_ORDER + 1) * D_HYENA + 4 * D_RET

kernel_name = 'hybrid_hyena_retention_encoder'


def rmsnorm(x, g):
    xf = x.astype(jnp.float32)
    y = xf * lax.rsqrt(jnp.mean(xf * xf, axis=-1, keepdims=True) + NORM_EPS)
    return (y * g.astype(jnp.float32)).astype(x.dtype)


def swiglu(h, w1, w3, w2):
    return (jax.nn.silu(h @ w1) * (h @ w3)) @ w2


def short_conv(u, w, b):
    L = u.shape[1]
    up = jnp.pad(u, ((0, 0), (1, 1), (0, 0)))
    return up[:, :L] * w[0] + up[:, 1:L + 1] * w[1] + up[:, 2:] * w[2] + b


def hyena_filters(L, w1, b1, w2, b2, w3, b3, w4, freq):
    f32 = jnp.float32
    t = jnp.linspace(0.0, 1.0, L, dtype=f32)[:, None]
    w = 2.0 * math.pi * jnp.arange(L, dtype=f32)[:, None] / L
    fb = jnp.linspace(1e-4, FILT_BANDS - 1, FILT_BANDS, dtype=f32)[None, :]
    z = jnp.concatenate([t, jnp.cos(fb * w), -jnp.sin(fb * w)], axis=-1)
    fr = freq.astype(f32)
    h = jnp.sin(fr * (z @ w1.astype(f32) + b1.astype(f32)))
    h = jnp.sin(fr * (h @ w2.astype(f32) + b2.astype(f32)))
    h = jnp.sin(fr * (h @ w3.astype(f32) + b3.astype(f32)))
    h = h @ w4.astype(f32)
    min_decay = math.log(HYENA_TARGET) / SLOW_DECAY_PCT
    max_decay = math.log(HYENA_TARGET) / FAST_DECAY_PCT
    deltas = jnp.linspace(min_decay, max_decay, D_HYENA, dtype=f32)
    window = jnp.exp(-t * jnp.abs(deltas)[None, :])
    h = h.reshape(L, HYENA_ORDER, 2, D_HYENA) * window[:, None, None, :]
    h = h / jnp.sum(jnp.abs(h), axis=0, keepdims=True)
    return jnp.transpose(h, (1, 2, 0, 3))


def bidir_long_conv(z, hf, hb):
    L = z.shape[1]
    k = jnp.concatenate([hf, jnp.zeros((1, hf.shape[1]), hf.dtype), hb[1:][::-1]], axis=0)
    Z = jnp.fft.rfft(z, n=2 * L, axis=1)
    K = jnp.fft.rfft(k, n=2 * L, axis=0)
    return jnp.fft.irfft(Z * K[None], n=2 * L, axis=1)[:, :L]


def hyena_mixer(u, sw, sb, fw1, fb1, fw2, fb2, fw3, fb3, fw4, freq, bias):
    L = u.shape[1]
    u = short_conv(u, sw, sb).astype(jnp.float32)
    v = u[..., :D_HYENA]
    gates = (u[..., D_HYENA:2 * D_HYENA], u[..., 2 * D_HYENA:])
    hs = hyena_filters(L, fw1, fb1, fw2, fb2, fw3, fb3, fw4, freq)
    bias = bias.astype(jnp.float32)
    z = v
    for n in range(HYENA_ORDER):
        z = gates[n] * (bidir_long_conv(z, hs[n, 0], hs[n, 1]) + bias[n] * z)
    return z


def rotary(x):
    L, d = x.shape[2], x.shape[3]
    inv = 1.0 / (ROPE_BASE ** (jnp.arange(0, d, 2, dtype=jnp.float32) / d))
    ang = jnp.arange(L, dtype=jnp.float32)[:, None] * inv[None, :]
    c, s = jnp.cos(ang), jnp.sin(ang)
    x1, x2 = x[..., :d // 2], x[..., d // 2:]
    return jnp.concatenate([x1 * c - x2 * s, x1 * s + x2 * c], axis=-1)


def retention_one_dir(q, k, v, lg, inclusive):
    B, H, L, d = q.shape
    C = RET_CHUNK
    n = L // C
    idx = jnp.arange(C, dtype=jnp.float32)
    diff = idx[:, None] - idx[None, :]
    mask = (diff >= 0) if inclusive else (diff > 0)
    Dm = jnp.where(mask[None], jnp.exp(jnp.maximum(diff, 0.0)[None] * lg[:, None, None]), 0.0)
    qc = q.reshape(B, H, n, C, d)
    kc = k.reshape(B, H, n, C, d)
    vc = v.reshape(B, H, n, C, d)
    s = jnp.einsum('bhncd,bhnjd->bhncj', qc, kc) * Dm[None, :, None]
    intra = jnp.einsum('bhncj,bhnje->bhnce', s, vc)
    wk = jnp.exp((C - 1 - idx)[None, :] * lg[:, None])
    wq = jnp.exp((idx + 1)[None, :] * lg[:, None])
    gC = jnp.exp(C * lg)
    kw = kc * wk[None, :, None, :, None]
    xs = (jnp.moveaxis(kw, 2, 0), jnp.moveaxis(vc, 2, 0))

    def step(R, kv):
        kk, vv = kv
        Rn = R * gC[None, :, None, None] + jnp.einsum('bhcd,bhce->bhde', kk, vv)
        return Rn, R

    _, states = lax.scan(step, jnp.zeros((B, H, d, d), jnp.float32), xs)
    cross = jnp.einsum('bhncd,nbhde->bhnce', qc * wq[None, :, None, :, None], states)
    return (intra + cross).reshape(B, H, L, d)


def retention_mixer(u, lg_f, lg_b):
    B, L, _ = u.shape
    u = u.astype(jnp.float32)

    def heads(t):
        return t.reshape(B, L, N_RET_HEADS, RET_HEAD_DIM).transpose(0, 2, 1, 3)

    q = rotary(heads(u[..., :D_RET]))
    k = rotary(heads(u[..., D_RET:2 * D_RET])) * (RET_HEAD_DIM ** -0.5)
    v = heads(u[..., 2 * D_RET:3 * D_RET])
    g = u[..., 3 * D_RET:]
    lg_f = lg_f.astype(jnp.float32)
    lg_b = lg_b.astype(jnp.float32)
    o_f = retention_one_dir(q, k, v, lg_f, True)
    o_b = jnp.flip(retention_one_dir(jnp.flip(q, 2), jnp.flip(k, 2), jnp.flip(v, 2), lg_b, False), 2)
    o = o_f + o_b
    o = o * lax.rsqrt(jnp.mean(o * o, axis=-1, keepdims=True) + NORM_EPS)
    o = o.transpose(0, 2, 1, 3).reshape(B, L, D_RET)
    return jax.nn.silu(g) * o


def _layer(x, p):
    h = rmsnorm(x, p['ffn1_pre_g'])
    x = x + 0.5 * rmsnorm(swiglu(h, p['ffn1_w1'], p['ffn1_w3'], p['ffn1_w2']), p['ffn1_post_g'])
    h = rmsnorm(x, p['mix_pre_g'])
    u = h @ p['w_in']
    nh = (HYENA_ORDER + 1) * D_HYENA
    y_h = hyena_mixer(u[..., :nh], p['short_w'], p['short_b'], p['filt_w1'], p['filt_b1'],
                      p['filt_w2'], p['filt_b2'], p['filt_w3'], p['filt_b3'], p['filt_w4'],
                      p['filt_freq'], p['hyena_bias'])
    y_r = retention_mixer(u[..., nh:], p['ret_log_decay_f'], p['ret_log_decay_b'])
    y = jnp.concatenate([y_h, y_r], axis=-1).astype(x.dtype) @ p['w_out']
    x = x + rmsnorm(y, p['mix_post_g'])
    h = rmsnorm(x, p['ffn2_pre_g'])
    x = x + 0.5 * rmsnorm(swiglu(h, p['ffn2_w1'], p['ffn2_w3'], p['ffn2_w2']), p['ffn2_post_g'])
    return x


def setup_inputs(seed: int = 0) -> dict:
    key = jax.random.key(seed)
    ks = jax.random.split(key, 32)
    f32 = jnp.float32

    def nrm(k, shape, scale):
        return jax.random.normal(k, shape, f32) * scale

    def gain(k):
        return 1.0 + 0.02 * jax.random.normal(k, (DEPTH, D_MODEL), f32)

    base = jnp.log(1.0 - 2.0 ** (-5.0 - jnp.arange(N_RET_HEADS, dtype=f32)))
    return {
        'x_prompt': jax.random.normal(ks[0], (BATCH, SEQ, D_MODEL), f32),
        'x_sample': jax.random.normal(ks[1], (DEC_BATCH, DEC_SEQ, D_MODEL), f32),
        'ffn1_pre_g': gain(ks[2]),
        'ffn1_w1': nrm(ks[3], (DEPTH, D_MODEL, D_FF), D_MODEL ** -0.5),
        'ffn1_w3': nrm(ks[4], (DEPTH, D_MODEL, D_FF), D_MODEL ** -0.5),
        'ffn1_w2': nrm(ks[5], (DEPTH, D_FF, D_MODEL), D_FF ** -0.5),
        'ffn1_post_g': gain(ks[6]),
        'mix_pre_g': gain(ks[7]),
        'w_in': nrm(ks[8], (DEPTH, D_MODEL, D_IN), D_MODEL ** -0.5),
        'short_w': nrm(ks[9], (DEPTH, 3, (HYENA_ORDER + 1) * D_HYENA), 3 ** -0.5),
        'short_b': nrm(ks[10], (DEPTH, (HYENA_ORDER + 1) * D_HYENA), 0.02),
        'filt_w1': nrm(ks[11], (DEPTH, FILT_EMB, FILT_HIDDEN), FILT_EMB ** -0.5),
        'filt_b1': nrm(ks[12], (DEPTH, FILT_HIDDEN), 0.1),
        'filt_w2': nrm(ks[13], (DEPTH, FILT_HIDDEN, FILT_HIDDEN), FILT_HIDDEN ** -0.5),
        'filt_b2': nrm(ks[14], (DEPTH, FILT_HIDDEN), 0.1),
        'filt_w3': nrm(ks[15], (DEPTH, FILT_HIDDEN, FILT_HIDDEN), FILT_HIDDEN ** -0.5),
        'filt_b3': nrm(ks[16], (DEPTH, FILT_HIDDEN), 0.1),
        'filt_w4': nrm(ks[17], (DEPTH, FILT_HIDDEN, HYENA_ORDER * 2 * D_HYENA), FILT_HIDDEN ** -0.5),
        'filt_freq': 1.0 + 0.1 * jax.random.normal(ks[18], (DEPTH, FILT_HIDDEN), f32),
        'hyena_bias': nrm(ks[19], (DEPTH, HYENA_ORDER, D_HYENA), 0.1),
        'ret_log_decay_f': base[None, :] * (1.0 + 0.02 * jax.random.normal(ks[20], (DEPTH, N_RET_HEADS), f32)),
        'ret_log_decay_b': base[None, :] * (1.0 + 0.02 * jax.random.normal(ks[21], (DEPTH, N_RET_HEADS), f32)),
        'w_out': nrm(ks[22], (DEPTH, D_MIX, D_MODEL), D_MIX ** -0.5),
        'mix_post_g': gain(ks[23]),
        'ffn2_pre_g': gain(ks[24]),
        'ffn2_w1': nrm(ks[25], (DEPTH, D_MODEL, D_FF), D_MODEL ** -0.5),
        'ffn2_w3': nrm(ks[26], (DEPTH, D_MODEL, D_FF), D_MODEL ** -0.5),
        'ffn2_w2': nrm(ks[27], (DEPTH, D_FF, D_MODEL), D_FF ** -0.5),
        'ffn2_post_g': gain(ks[28]),
    }


def reference(x_prompt, x_sample, ffn1_pre_g, ffn1_w1, ffn1_w3, ffn1_w2, ffn1_post_g,
              mix_pre_g, w_in, short_w, short_b, filt_w1, filt_b1, filt_w2, filt_b2,
              filt_w3, filt_b3, filt_w4, filt_freq, hyena_bias, ret_log_decay_f,
              ret_log_decay_b, w_out, mix_post_g, ffn2_pre_g, ffn2_w1, ffn2_w3, ffn2_w2,
              ffn2_post_g):
    def run(x):
        for l in range(DEPTH):
            p = dict(ffn1_pre_g=ffn1_pre_g[l], ffn1_w1=ffn1_w1[l], ffn1_w3=ffn1_w3[l],
                     ffn1_w2=ffn1_w2[l], ffn1_post_g=ffn1_post_g[l], mix_pre_g=mix_pre_g[l],
                     w_in=w_in[l], short_w=short_w[l], short_b=short_b[l],
                     filt_w1=filt_w1[l], filt_b1=filt_b1[l], filt_w2=filt_w2[l],
                     filt_b2=filt_b2[l], filt_w3=filt_w3[l], filt_b3=filt_b3[l],
                     filt_w4=filt_w4[l], filt_freq=filt_freq[l], hyena_bias=hyena_bias[l],
                     ret_log_decay_f=ret_log_decay_f[l], ret_log_decay_b=ret_log_decay_b[l],
                     w_out=w_out[l], mix_post_g=mix_post_g[l], ffn2_pre_g=ffn2_pre_g[l],
                     ffn2_w1=ffn2_w1[l], ffn2_w3=ffn2_w3[l], ffn2_w2=ffn2_w2[l],
                     ffn2_post_g=ffn2_post_g[l])
            x = _layer(x, p)
        return x

    y_prompt = run(x_prompt)
    y_sample = run(x_sample)
    return (y_prompt, y_sample)
```

```cpp
#include <hip/hip_runtime.h>
#include <hip/hip_fp16.h>
#include <hip/hip_cooperative_groups.h>
#include <cstdio>
namespace cg = cooperative_groups;

#define LAS __attribute__((address_space(3)))
typedef unsigned short bf16_t;
typedef short bf16x8 __attribute__((ext_vector_type(8)));
typedef float f32x4 __attribute__((ext_vector_type(4)));
typedef float v2f __attribute__((ext_vector_type(2)));
typedef unsigned u32x4 __attribute__((ext_vector_type(4)));
typedef unsigned u32x2 __attribute__((ext_vector_type(2)));

#ifndef EXTRA_SYNCS
#define EXTRA_SYNCS 0
#endif
#ifndef REP7
#define REP7 1
#endif
#ifndef REP5
#define REP5 1
#endif
#ifndef REP_TR
#define REP_TR 1
#endif
#ifndef REP_FILT
#define REP_FILT 1
#endif
#ifndef REP_ROW0
#define REP_ROW0 1
#endif
constexpr int T_ALL = 49152, T_P = 16384;
constexpr size_t U_BYTES = (size_t)T_ALL * 1024 * 2;
constexpr size_t SZ_WUP = (size_t)5632 * 1024 * 2, SZ_WDN = (size_t)1024 * 2816 * 2, SZ_WIN = (size_t)4096 * 1024 * 2, SZ_WOUT = (size_t)1024 * 1024 * 2;
constexpr size_t SZ_ROT = (size_t)8192 * 64 * 8, SZ_HRAW = (size_t)2048 * 12288 * 2;
constexpr size_t OFF_WUP1 = 0, OFF_WDN1 = OFF_WUP1 + SZ_WUP, OFF_WIN = OFF_WDN1 + SZ_WDN, OFF_WOUT = OFF_WIN + SZ_WIN, OFF_WUP2 = OFF_WOUT + SZ_WOUT,
                 OFF_WDN2 = OFF_WUP2 + SZ_WUP, OFF_ROT = OFF_WDN2 + SZ_WDN, OFF_ROTT = OFF_ROT + SZ_ROT, OFF_HRAW = OFF_ROTT + SZ_ROT, OFF_BIG = OFF_HRAW + SZ_HRAW;
constexpr size_t OFF_G = OFF_BIG;
constexpr size_t OFF_CT = OFF_BIG;
constexpr size_t OFF_Q = OFF_CT + 2 * U_BYTES;
constexpr size_t OFF_K = OFF_Q + U_BYTES / 2;
constexpr size_t OFF_SG = OFF_K + U_BYTES / 2;
constexpr size_t OFF_KT = OFF_SG + U_BYTES / 2;
constexpr size_t WS_END = OFF_KT + U_BYTES / 2;
static_assert(WS_END + (size_t)256 * 65536 + 16384 <= (size_t)536870912, "workspace");
constexpr size_t OFF_BAR = WS_END + (size_t)256 * 65536;
constexpr int FFT_BYTES = 143360;
constexpr int SMEM_BYTES = FFT_BYTES + 1024 + 16384;

struct Params {
    const float* in[29];
    float* out;
    char* ws;
    int ph_lo, ph_hi;
};

__device__ __forceinline__ unsigned short f2bf(float f) { unsigned u = __float_as_uint(f); u += 0x7fffu + ((u >> 16) & 1u); return (unsigned short)(u >> 16); }
__device__ __forceinline__ float bf2f(unsigned short h) { return __uint_as_float(((unsigned)h) << 16); }
__device__ __forceinline__ unsigned pack_bf(float lo, float hi) { unsigned r; asm("v_cvt_pk_bf16_f32 %0, %1, %2" : "=v"(r) : "v"(lo), "v"(hi)); return r; }
__device__ __forceinline__ float bflo(unsigned w) { return __uint_as_float(w << 16); }
__device__ __forceinline__ float bfhi(unsigned w) { return __uint_as_float(w & 0xffff0000u); }
__device__ __forceinline__ int row_base(int bb) { return bb < 4 ? bb * 4096 : 16384 + (bb - 4) * 8192; }
__device__ __forceinline__ void row_info(int r, int& rb, int& L) { if (r < T_P) { L = 4096; rb = r & ~4095; } else { L = 8192; rb = T_P + ((r - T_P) & ~8191); } }
__device__ __forceinline__ float wave_sum(float v) {
#pragma unroll
    for (int o = 32; o; o >>= 1) v += __shfl_xor(v, o);
    return v;
}
__device__ __forceinline__ float silu_f(float x) { return x * __builtin_amdgcn_rcpf(1.0f + __builtin_amdgcn_exp2f(x * -1.4426950408889634f)); }
namespace pg8 {
constexpr int BM = 256, BK = 64, HALF = 128, HTB = HALF * BK * 2, STAGE_BYTES = 8 * HTB, NXCD = 8, WGM = 8;
__device__ __forceinline__ int lds_byte(int r, int c) { const int st = (r >> 4) * 2 + (c >> 5), rr = r & 15, cc = c & 31, ob = rr * 64 + cc * 2; return st * 1024 + (ob ^ (((ob >> 9) & 1) << 5)); }
__device__ __forceinline__ void stage_rc(int b, int& R, int& C) { const int st = b / 1024, sb = b % 1024, swz = sb ^ (((sb >> 9) & 1) << 5); R = (st >> 1) * 16 + swz / 64; C = (st & 1) * 32 + (swz % 64) / 2; }
__device__ __forceinline__ int perm32(int rho) { const int n = rho >> 4, i = rho & 15; return 8 * (i >> 2) + 4 * n + (i & 3); }
struct Unit { int pm, pn; };
struct Gemm { const bf16_t* A; const bf16_t* Bt; int M, N, K, lda, ldb, ksplit; long asplit; };
struct StaticOrder {
    int nM, nN, nwg, G, c;
    __device__ void init(int M, int N, int G_, int c_) { nM = M / BM; nN = N / BM; nwg = nM * nN; G = G_; c = c_; }
    __device__ bool next(int i, Unit& u) const {
        const long L = (long)i * G + c; if (L >= nwg) return false;
        int wgid = (int)L; { const int q = nwg / NXCD, r = nwg % NXCD, xcd = wgid % NXCD, off = wgid / NXCD; wgid = (xcd < r ? xcd * (q + 1) : r * (q + 1) + (xcd - r) * q) + off; }
        const int nig = WGM * nN, gid = wgid / nig, fm = gid * WGM, gsz = (nM - fm) < WGM ? (nM - fm) : WGM;
        u.pm = fm + ((wgid % nig) % gsz); u.pn = (wgid % nig) / gsz; return true;
    }
};
__device__ __forceinline__ unsigned cvt_pk_bf16(float lo, float hi) { unsigned r; asm volatile("v_cvt_pk_bf16_f32 %0, %1, %2" : "=v"(r) : "v"(lo), "v"(hi)); return r; }

template <class Epi, class Sched>
__device__ __forceinline__ void gemm_phase(LAS unsigned char* lds, const Gemm g, const Sched& S, const Epi& E) {
    const int tid = threadIdx.x, wid = __builtin_amdgcn_readfirstlane(tid >> 6), lane = tid & 63, wr = wid >> 2, wc = wid & 3, fr = lane & 15, fq = lane >> 4;
    const int K = g.K, nt = K / BK;
    unsigned voffA[2], voffB[2];
#pragma unroll
    for (int i = 0; i < 2; ++i) { int R, C; stage_rc(tid * 16 + i * 8192, R, C); const int Rb = (R & ~31) + perm32(R & 31);
        voffA[i] = (unsigned)(R * g.lda + C) * 2u; voffB[i] = (unsigned)(Rb * g.ldb + C) * 2u; }
    const size_t kstep = (size_t)(BK * 2);
    const size_t hstepA = (size_t)HALF * g.lda * 2, hstepB = (size_t)HALF * g.ldb * 2;
    const size_t tstepA = 2 * hstepA, tstepB = 2 * hstepB;
    const unsigned ldsw = (unsigned)wid * 1024u;
    const int aoff = lds_byte(wr * 64 + fr, fq * 8), boff = lds_byte(wc * 32 + fr, fq * 8);
    const int ksplit = g.ksplit; const long asplit = g.asplit;
#define PG8_AP(base, t) ((base) + (size_t)(t) * kstep + (((t) >= ksplit) ? asplit : 0l))
#define PG8_SA(b, h) (((b) * 2 + (h)) * HTB)
#define PG8_SB(b, h) ((4 + (b) * 2 + (h)) * HTB)
#define PG8_STAGE(bufoff, gbase, voff) do { _Pragma("unroll") for (int _i = 0; _i < 2; ++_i) \
        __builtin_amdgcn_global_load_lds((const unsigned*)((const char*)(gbase) + (voff)[_i]), (LAS unsigned*)(lds + (bufoff) + ldsw + _i * 8192), 16, 0, 0); } while (0)
#define PG8_LDA(dst, b, h) do { _Pragma("unroll") for (int m = 0; m < 4; ++m) _Pragma("unroll") for (int k = 0; k < 2; ++k) dst[m][k] = *(const LAS bf16x8*)(lds + PG8_SA(b, h) + aoff + m * 2048 + k * 1024); } while (0)
#define PG8_LDB(dst, b, h) do { _Pragma("unroll") for (int n = 0; n < 2; ++n) _Pragma("unroll") for (int k = 0; k < 2; ++k) dst[n][k] = *(const LAS bf16x8*)(lds + PG8_SB(b, h) + boff + n * 2048 + k * 1024); } while (0)
#define PG8_MMA(ai, bj, At, Bt) do { __builtin_amdgcn_s_setprio(1); _Pragma("unroll") for (int m = 0; m < 4; ++m) _Pragma("unroll") for (int n = 0; n < 2; ++n) _Pragma("unroll") for (int k = 0; k < 2; ++k) \
        acc[ai][bj][m][n] = __builtin_amdgcn_mfma_f32_16x16x32_bf16(Bt[n][k], At[m][k], acc[ai][bj][m][n], 0, 0, 0); __builtin_amdgcn_s_setprio(0); } while (0)
#define PG8_WAIT_V(n) asm volatile("s_waitcnt vmcnt(" #n ")" ::: "memory")
#define PG8_WAIT_L(n) asm volatile("s_waitcnt lgkmcnt(" #n ")" ::: "memory")
#define PG8_BAR __builtin_amdgcn_s_barrier()
#define PG8_SCHED __builtin_amdgcn_sched_barrier(0)
    Unit cur, nxt; int ui = 0;
    if (!S.next(0, cur)) return;
    f32x4 acc[2][2][4][2];
#pragma unroll
    for (int a = 0; a < 2; ++a)
#pragma unroll
        for (int b = 0; b < 2; ++b)
#pragma unroll
            for (int m = 0; m < 4; ++m)
#pragma unroll
                for (int n = 0; n < 2; ++n) acc[a][b][m][n] = (f32x4){0.f, 0.f, 0.f, 0.f};
    bf16x8 At[4][2], B0[2][2], B1[2][2];
    const char* cA = (const char*)g.A + (size_t)cur.pm * tstepA; const char* cB = (const char*)g.Bt + (size_t)cur.pn * tstepB;
    PG8_STAGE(PG8_SB(0, 0), cB, voffB); PG8_STAGE(PG8_SA(0, 0), cA, voffA); PG8_STAGE(PG8_SB(0, 1), cB + hstepB, voffB); PG8_STAGE(PG8_SA(0, 1), cA + hstepA, voffA);
    if (wr == 1) PG8_BAR;
    PG8_WAIT_V(4); PG8_BAR;
    PG8_STAGE(PG8_SB(1, 0), cB + kstep, voffB); PG8_STAGE(PG8_SA(1, 0), cA + kstep, voffA); PG8_STAGE(PG8_SB(1, 1), cB + hstepB + kstep, voffB);
    PG8_WAIT_V(6); PG8_BAR;
    for (;;) {
        const bool has_next = S.next(ui + 1, nxt);
        const char* nA = has_next ? (const char*)g.A + (size_t)nxt.pm * tstepA : cA; const char* nB = has_next ? (const char*)g.Bt + (size_t)nxt.pn * tstepB : cB;
        for (int t = 0; t < nt; t += 2) {
            const bool last = (t == nt - 2);
            const char* a1 = PG8_AP(cA, t + 1);
            const char* a2 = last ? nA : PG8_AP(cA, t + 2); const char* b2 = last ? nB : cB + (size_t)(t + 2) * kstep;
            const char* a3 = last ? nA + kstep : PG8_AP(cA, t + 3); const char* b3 = b2 + kstep;
            PG8_LDB(B0, 0, 0); PG8_SCHED; PG8_LDA(At, 0, 0); PG8_STAGE(PG8_SA(1, 1), a1 + hstepA, voffA);
            PG8_WAIT_L(8); PG8_BAR; PG8_WAIT_L(0); PG8_MMA(0, 0, At, B0); PG8_BAR; PG8_SCHED;
            PG8_LDB(B1, 0, 1); PG8_STAGE(PG8_SB(0, 0), b2, voffB);
            PG8_BAR; PG8_WAIT_L(0); PG8_MMA(0, 1, At, B1); PG8_BAR;
            PG8_LDA(At, 0, 1); PG8_STAGE(PG8_SA(0, 0), a2, voffA);
            PG8_BAR; PG8_WAIT_L(0); PG8_MMA(1, 0, At, B0); PG8_BAR; PG8_SCHED;
            PG8_STAGE(PG8_SB(0, 1), b2 + hstepB, voffB);
            PG8_WAIT_V(6); PG8_BAR; PG8_MMA(1, 1, At, B1); PG8_BAR;
            PG8_LDB(B0, 1, 0); PG8_SCHED; PG8_LDA(At, 1, 0); PG8_STAGE(PG8_SA(0, 1), a2 + hstepA, voffA);
            PG8_WAIT_L(8); PG8_BAR; PG8_WAIT_L(0); PG8_MMA(0, 0, At, B0); PG8_BAR; PG8_SCHED;
            PG8_LDB(B1, 1, 1); PG8_STAGE(PG8_SB(1, 0), b3, voffB);
            PG8_BAR; PG8_WAIT_L(0); PG8_MMA(0, 1, At, B1); PG8_BAR;
            PG8_LDA(At, 1, 1); PG8_STAGE(PG8_SA(1, 0), a3, voffA);
            PG8_BAR; PG8_WAIT_L(0); PG8_MMA(1, 0, At, B0); PG8_BAR; PG8_SCHED;
            PG8_STAGE(PG8_SB(1, 1), b3 + hstepB, voffB);
            PG8_WAIT_V(6); PG8_BAR; PG8_MMA(1, 1, At, B1); PG8_BAR;
        }
        { int l2 = threadIdx.x & 63; asm volatile("" : "+v"(l2)); E(acc, cur, wr, wc, l2 & 15, l2 >> 4); }
        if (!has_next) break;
#pragma unroll
        for (int a = 0; a < 2; ++a)
#pragma unroll
            for (int b = 0; b < 2; ++b)
#pragma unroll
                for (int m = 0; m < 4; ++m)
#pragma unroll
                    for (int n = 0; n < 2; ++n) acc[a][b][m][n] = (f32x4){0.f, 0.f, 0.f, 0.f};
        cur = nxt; cA = nA; cB = nB; ++ui;
    }
    PG8_WAIT_V(0);
    if (wr == 0) PG8_BAR;
    PG8_BAR;
#undef PG8_AP
#undef PG8_SA
#undef PG8_SB
#undef PG8_STAGE
#undef PG8_LDA
#undef PG8_LDB
#undef PG8_MMA
#undef PG8_WAIT_V
#undef PG8_WAIT_L
#undef PG8_BAR
#undef PG8_SCHED
}

struct EpiBf16 {
    bf16_t* O; int ldc;
    __device__ __forceinline__ void operator()(const f32x4 (&acc)[2][2][4][2], const Unit& u, int wr, int wc, int fr, int fq) const {
        const int row0 = u.pm * BM + wr * 64 + fr, col0 = u.pn * BM + wc * 32 + 8 * fq;
#pragma unroll
        for (int ai = 0; ai < 2; ++ai)
#pragma unroll
            for (int m = 0; m < 4; ++m) { bf16_t* rowp = O + (size_t)(row0 + ai * HALF + m * 16) * ldc + col0;
#pragma unroll
                for (int bj = 0; bj < 2; ++bj) { const f32x4 v0 = acc[ai][bj][m][0], v1 = acc[ai][bj][m][1];
                    u32x4 w; w.x = cvt_pk_bf16(v0[0], v0[1]); w.y = cvt_pk_bf16(v0[2], v0[3]); w.z = cvt_pk_bf16(v1[0], v1[1]); w.w = cvt_pk_bf16(v1[2], v1[3]);
                    *(u32x4*)(rowp + bj * HALF) = w; } }
    }
};
struct EpiSwiglu {
    bf16_t* O; int ldc;
    __device__ __forceinline__ void operator()(const f32x4 (&acc)[2][2][4][2], const Unit& u, int wr, int wc, int fr, int fq) const {
        const int row0 = u.pm * BM + wr * 64 + fr, col0 = u.pn * HALF + wc * 32 + 8 * fq;
#pragma unroll
        for (int ai = 0; ai < 2; ++ai)
#pragma unroll
            for (int m = 0; m < 4; ++m) { bf16_t* rowp = O + (size_t)(row0 + ai * HALF + m * 16) * ldc + col0;
                float r[8];
#pragma unroll
                for (int n = 0; n < 2; ++n)
#pragma unroll
                    for (int j = 0; j < 4; ++j) { const float gt = acc[ai][0][m][n][j], up = acc[ai][1][m][n][j]; r[n * 4 + j] = silu_f(gt) * up; }
                u32x4 w; w.x = cvt_pk_bf16(r[0], r[1]); w.y = cvt_pk_bf16(r[2], r[3]); w.z = cvt_pk_bf16(r[4], r[5]); w.w = cvt_pk_bf16(r[6], r[7]);
                *(u32x4*)rowp = w; }
    }
};
struct EpiCT {
    bf16_t* CT;
    __device__ __forceinline__ void operator()(const f32x4 (&acc)[2][2][4][2], const Unit& u, int wr, int wc, int fr, int fq) const {
        const int r0 = u.pn * BM; int rb, L; row_info(r0, rb, L);
        const int tloc = (r0 - rb) + wc * 32 + 8 * fq;
        {
            bf16_t* base = CT + (size_t)rb * 2048 + tloc;
#pragma unroll
            for (int ai = 0; ai < 2; ++ai)
#pragma unroll
                for (int m = 0; m < 4; ++m) { const int ch = u.pm * BM + ai * HALF + wr * 64 + m * 16 + fr; bf16_t* rowp = base + (size_t)ch * L;
#pragma unroll
                    for (int bj = 0; bj < 2; ++bj) { const f32x4 v0 = acc[ai][bj][m][0], v1 = acc[ai][bj][m][1];
                        u32x4 w; w.x = cvt_pk_bf16(v0[0], v0[1]); w.y = cvt_pk_bf16(v0[2], v0[3]); w.z = cvt_pk_bf16(v1[0], v1[1]); w.w = cvt_pk_bf16(v1[2], v1[3]);
                        *(u32x4*)(rowp + bj * HALF) = w; } }
        }
    }
};
struct EpiQKG {
    bf16_t* Q; bf16_t* Kk; bf16_t* SG; const v2f* rot;
    __device__ __forceinline__ void operator()(const f32x4 (&acc)[2][2][4][2], const Unit& u, int wr, int wc, int fr, int fq) const {
        const int row0 = u.pm * BM + wr * 64 + fr; int rb, L; row_info(u.pm * BM, rb, L);
        if (u.pn < 4) {
            bf16_t* O = (u.pn < 2) ? Q : Kk; const float sc = (u.pn < 2) ? 1.0f : 0.08838834764831845f;
            const int head = 2 * (u.pn & 1) + (wc >> 1), dd0 = (wc & 1) * 32 + 8 * fq;
            f32x4 cb[4], s16[4], s128[4];
            { const v2f* rp = rot + (size_t)(row0 - rb) * 64 + dd0; const v2f* r16 = rot + (size_t)16 * 64 + dd0; const v2f* r128 = rot + (size_t)128 * 64 + dd0;
#pragma unroll
              for (int i = 0; i < 4; ++i) { cb[i] = *(const f32x4*)(rp + 2 * i); s16[i] = *(const f32x4*)(r16 + 2 * i); s128[i] = *(const f32x4*)(r128 + 2 * i); } }
#pragma unroll
            for (int ai = 0; ai < 2; ++ai) {
                f32x4 cur[4];
#pragma unroll
                for (int i = 0; i < 4; ++i) { cur[i] = cb[i];
                    if (ai == 1) { f32x4 t; t[0] = cb[i][0] * s128[i][0] - cb[i][1] * s128[i][1]; t[1] = cb[i][0] * s128[i][1] + cb[i][1] * s128[i][0];
                        t[2] = cb[i][2] * s128[i][2] - cb[i][3] * s128[i][3]; t[3] = cb[i][2] * s128[i][3] + cb[i][3] * s128[i][2]; cur[i] = t; } }
#pragma unroll
                for (int m = 0; m < 4; ++m) { const int row = row0 + ai * HALF + m * 16;
                    if (m > 0) {
#pragma unroll
                        for (int i = 0; i < 4; ++i) { f32x4 t; t[0] = cur[i][0] * s16[i][0] - cur[i][1] * s16[i][1]; t[1] = cur[i][0] * s16[i][1] + cur[i][1] * s16[i][0];
                            t[2] = cur[i][2] * s16[i][2] - cur[i][3] * s16[i][3]; t[3] = cur[i][2] * s16[i][3] + cur[i][3] * s16[i][2]; cur[i] = t; } }
                    float o1[8], o2[8];
#pragma unroll
                    for (int n = 0; n < 2; ++n)
#pragma unroll
                        for (int j = 0; j < 4; ++j) { const int k = n * 4 + j; const float c = cur[k >> 1][(k & 1) * 2], sn = cur[k >> 1][(k & 1) * 2 + 1];
                            const float x1 = acc[ai][0][m][n][j], x2 = acc[ai][1][m][n][j];
                            o1[k] = (x1 * c - x2 * sn) * sc; o2[k] = (x1 * sn + x2 * c) * sc; }
                    bf16_t* dst = O + (size_t)row * 512 + head * 128 + dd0;
                    u32x4 w; w.x = cvt_pk_bf16(o1[0], o1[1]); w.y = cvt_pk_bf16(o1[2], o1[3]); w.z = cvt_pk_bf16(o1[4], o1[5]); w.w = cvt_pk_bf16(o1[6], o1[7]);
                    *(u32x4*)dst = w;
                    w.x = cvt_pk_bf16(o2[0], o2[1]); w.y = cvt_pk_bf16(o2[2], o2[3]); w.z = cvt_pk_bf16(o2[4], o2[5]); w.w = cvt_pk_bf16(o2[6], o2[7]);
                    *(u32x4*)(dst + 64) = w; } }
        } else {
            const int col0 = (u.pn - 4) * BM + wc * 32 + 8 * fq;
#pragma unroll
            for (int ai = 0; ai < 2; ++ai)
#pragma unroll
                for (int m = 0; m < 4; ++m) { bf16_t* rowp = SG + (size_t)(row0 + ai * HALF + m * 16) * 512 + col0;
#pragma unroll
                    for (int bj = 0; bj < 2; ++bj) { const f32x4 v0 = acc[ai][bj][m][0], v1 = acc[ai][bj][m][1];
                        u32x4 w; w.x = cvt_pk_bf16(silu_f(v0[0]), silu_f(v0[1])); w.y = cvt_pk_bf16(silu_f(v0[2]), silu_f(v0[3]));
                        w.z = cvt_pk_bf16(silu_f(v1[0]), silu_f(v1[1])); w.w = cvt_pk_bf16(silu_f(v1[2]), silu_f(v1[3]));
                        *(u32x4*)(rowp + bj * HALF) = w; } }
        }
    }
};
}
#define FFT_HD __device__ __forceinline__

FFT_HD v2f cmul(v2f a, v2f b) {
    v2f t, r;
    asm("v_pk_mul_f32 %0, %1, %2 op_sel_hi:[0,1]" : "=v"(t) : "v"(a), "v"(b));
    asm("v_pk_fma_f32 %0, %1, %2, %3 op_sel:[1,1,0] op_sel_hi:[1,0,1] neg_lo:[1,0,0]" : "=v"(r) : "v"(a), "v"(b), "v"(t));
    return r;
}
FFT_HD constexpr int brev_c(int x, int bits) { int r = 0; for (int i = 0; i < bits; ++i) r |= ((x >> i) & 1) << (bits - 1 - i); return r; }
template <int R> struct Log2R { static constexpr int v = (R == 32) ? 5 : (R == 16) ? 4 : (R == 8) ? 3 : (R == 4) ? 2 : 1; };
FFT_HD constexpr float cos32c(int i) {
    switch (i & 15) {
        case 0: return 1.0f; case 1: return 0.98078528040323043f; case 2: return 0.92387953251128674f; case 3: return 0.83146961230254524f;
        case 4: return 0.70710678118654752f; case 5: return 0.55557023301960218f; case 6: return 0.38268343236508977f; case 7: return 0.19509032201612825f;
        case 8: return 0.0f; case 9: return -0.19509032201612825f; case 10: return -0.38268343236508977f; case 11: return -0.55557023301960218f;
        case 12: return -0.70710678118654752f; case 13: return -0.83146961230254524f; case 14: return -0.92387953251128674f; default: return -0.98078528040323043f;
    }
}
FFT_HD constexpr float sin32c(int i) {
    switch (i & 15) {
        case 0: return 0.0f; case 1: return 0.19509032201612825f; case 2: return 0.38268343236508977f; case 3: return 0.55557023301960218f;
        case 4: return 0.70710678118654752f; case 5: return 0.83146961230254524f; case 6: return 0.92387953251128674f; case 7: return 0.98078528040323043f;
        case 8: return 1.0f; case 9: return 0.98078528040323043f; case 10: return 0.92387953251128674f; case 11: return 0.83146961230254524f;
        case 12: return 0.70710678118654752f; case 13: return 0.55557023301960218f; case 14: return 0.38268343236508977f; default: return 0.19509032201612825f;
    }
}
template <int R, bool INV> FFT_HD void dftR(v2f (&v)[R]) {
#pragma unroll
    for (int half = R / 2; half >= 1; half >>= 1) {
#pragma unroll
        for (int i = 0; i < R; ++i) {
            if ((i & half) == 0) {
                const int j = i + half;
                const int p = (i & (half - 1)) * (16 / half);
                const v2f a = v[i], b = v[j];
                v[i] = a + b;
                const v2f d = a - b;
                if (p == 0) { v[j] = d; }
                else if (p == 8) { v2f r; if (INV) { r.x = -d.y; r.y = d.x; } else { r.x = d.y; r.y = -d.x; } v[j] = r; }
                else {
                    const float c = cos32c(p), s = sin32c(p);
                    const v2f dsw = __builtin_shufflevector(d, d, 1, 0);
                    v2f sv; sv.x = INV ? -s : s; sv.y = INV ? s : -s;
                    v[j] = d * c + dsw * sv;
                }
            }
        }
    }
}
template <int R> FFT_HD void tw_brev(v2f (&v)[R], v2f w) {
    v2f wk = w;
#pragma unroll
    for (int k = 1; k < R; ++k) { const int i = brev_c(k, Log2R<R>::v); v[i] = cmul(v[i], wk); wk = cmul(wk, w); }
}
template <int R> FFT_HD void tw_nat(v2f (&v)[R], v2f w) {
    v2f wk = w;
#pragma unroll
    for (int k = 1; k < R; ++k) { v[k] = cmul(v[k], wk); wk = cmul(wk, w); }
}
FFT_HD int opaque_i(int x) {
#if defined(__HIP_DEVICE_COMPILE__)
    asm volatile("" : "+v"(x));
#endif
    return x;
}
FFT_HD v2f unit_root(float frac2  , bool conj) {
    float s, c;
    sincospif(frac2, &s, &c);
    v2f w; w.x = c; w.y = conj ? s : -s; return w;
}

template <int N1_, int N2_, int N3_, int NT_> struct FftCfg {
    static constexpr int N1 = N1_, N2 = N2_, N3 = N3_, NT = NT_, N = N1_ * N2_ * N3_, S1 = N2_ * N3_;
    static constexpr int RS0 = S1 + S1 / 16;
    static constexpr int RS = RS0 + (((RS0 * 2) % 64 == 0) ? 16 : 0);
    static constexpr int PHYS = N1_ * RS;
    static constexpr int P2 = (N1_ * N3_) / NT_;
    static constexpr int P3 = (N1_ * N2_) / NT_;
};

template <class C, class BUF> FFT_HD void pass1_fwd(v2f (&v)[32], int lt, BUF buf) {
    static_assert(C::N1 == 32 && C::S1 == C::NT, "cfg");
    dftR<32, false>(v);
    tw_brev<32>(v, unit_root(2.0f * (float)opaque_i(lt) / (float)C::N, false));
#pragma unroll
    for (int k = 0; k < 32; ++k) buf[lt + (lt >> 4) + k * C::RS] = v[brev_c(k, 5)];
}
template <class C, bool INV, class BUF> FFT_HD void pass2(int lt, BUF buf) {
#pragma unroll 1
    for (int q = 0; q < C::P2; ++q) {
        const int d = lt + q * C::NT, k1 = d / C::N3, n3 = d % C::N3, base = k1 * C::RS + n3;
        v2f v[C::N2];
#pragma unroll
        for (int j = 0; j < C::N2; ++j) v[j] = buf[base + j * 17];
        const v2f w = unit_root(2.0f * (float)opaque_i(n3) / (float)(C::N2 * C::N3), INV);
        if (!INV) { dftR<C::N2, false>(v); tw_brev<C::N2>(v, w); }
        else      { tw_nat<C::N2>(v, w); dftR<C::N2, true>(v); }
#pragma unroll
        for (int k = 0; k < C::N2; ++k) buf[base + k * 17] = v[brev_c(k, Log2R<C::N2>::v)];
    }
}
template <class C, class BUF> FFT_HD void pass3_filter(int lt, BUF buf, unsigned* ks, float bias) {
    static_assert(C::N3 == 16, "cfg");
#pragma unroll
    for (int q = 0; q < C::P3; ++q) {
        const int dd = lt + q * C::NT, base = (dd / C::N2) * C::RS + (dd % C::N2) * 17;
        v2f v[16];
#pragma unroll
        for (int j = 0; j < 16; ++j) v[j] = buf[base + j];
        dftR<16, false>(v);
#pragma unroll
        for (int k = 0; k < 16; ++k) { const v2f x = v[brev_c(k, 4)]; const __half2 hh = __floats2half2_rn(x.x + bias, x.y);
            ks[(q * 16 + k) * C::NT + lt] = __builtin_bit_cast(unsigned, hh); }
    }
}
template <class C, class BUF> FFT_HD void pass3_fused(int lt, BUF buf, const unsigned* ks) {
#pragma unroll
    for (int q = 0; q < C::P3; ++q) {
        const int dd = lt + q * C::NT, base = (dd / C::N2) * C::RS + (dd % C::N2) * 17;
        v2f v[16], u[16];
        unsigned kw[16];
#pragma unroll
        for (int k = 0; k < 16; ++k) kw[k] = ks[(q * 16 + k) * C::NT + lt];
#pragma unroll
        for (int j = 0; j < 16; ++j) v[j] = buf[base + j];
        dftR<16, false>(v);
#pragma unroll
        for (int k = 0; k < 16; ++k) { const float2 kf = __half22float2(__builtin_bit_cast(__half2, kw[k])); v2f kk; kk.x = kf.x; kk.y = kf.y; u[k] = cmul(v[brev_c(k, 4)], kk); }
        dftR<16, true>(u);
#pragma unroll
        for (int n = 0; n < 16; ++n) buf[base + n] = u[brev_c(n, 4)];
    }
}
template <class C, class BUF> FFT_HD void pass1_inv(v2f (&v)[32], int lt, BUF buf) {
#pragma unroll
    for (int k = 0; k < 32; ++k) v[k] = buf[lt + (lt >> 4) + k * C::RS];
    tw_nat<32>(v, unit_root(2.0f * (float)opaque_i(lt) / (float)C::N, true));
    dftR<32, true>(v);
}

__device__ __forceinline__ int perm_qk(int x) { const int head = x >> 7, d = x & 127; return (head >> 1) * 256 + (d >> 6) * 128 + (head & 1) * 64 + (d & 63); }

__device__ void transpose_strip(const float* __restrict__ src, int srcN, int k0, int n0, bf16_t* dst, int dstld, int job, LAS float* tile) {
    const int tid = opaque_i(threadIdx.x);
    {
        const int nn = tid & 255, kb = tid >> 8;
        float r[32];
#pragma unroll
        for (int i = 0; i < 32; ++i) r[i] = src[(size_t)(k0 + kb + 2 * i) * srcN + n0 + nn];
#pragma unroll
        for (int i = 0; i < 32; ++i) tile[(kb + 2 * i) * 257 + nn] = r[i];
    }
    __syncthreads();
    const int nn = tid >> 1, kh = (tid & 1) * 32, n = n0 + nn;
    int row = n;
    if (job == 0) row = (n >> 7) * 256 + (n & 127);
    else if (job == 1) row = (n >> 7) * 256 + 128 + (n & 127);
    else if (job == 3) {
        if (n < 1536) row = n;
        else if (n < 2048) row = 2048 + perm_qk(n - 1536);
        else if (n < 2560) row = 2560 + perm_qk(n - 2048);
        else if (n < 3072) row = 1536 + (n - 2560);
        else row = 3072 + (n - 3072);
    }
    bf16_t* dp = dst + (size_t)row * dstld + k0 + kh;
#pragma unroll
    for (int q = 0; q < 4; ++q) { const int kk = kh + q * 8;
        u32x4 w;
        w.x = pack_bf(tile[(kk + 0) * 257 + nn], tile[(kk + 1) * 257 + nn]); w.y = pack_bf(tile[(kk + 2) * 257 + nn], tile[(kk + 3) * 257 + nn]);
        w.z = pack_bf(tile[(kk + 4) * 257 + nn], tile[(kk + 5) * 257 + nn]); w.w = pack_bf(tile[(kk + 6) * 257 + nn], tile[(kk + 7) * 257 + nn]);
        *(u32x4*)(dp + q * 8) = w; }
    __syncthreads();
}

__device__ void phase0_transposes(const Params& p, LAS float* tile) {
    for (int t = blockIdx.x; t < 1344 * REP_TR; t += gridDim.x) {
        int r = t % 1344;
        if (r < 176) { transpose_strip(p.in[3], 2816, (r / 11) * 64, (r % 11) * 256, (bf16_t*)(p.ws + OFF_WUP1), 1024, 0, tile); continue; } r -= 176;
        if (r < 176) { transpose_strip(p.in[4], 2816, (r / 11) * 64, (r % 11) * 256, (bf16_t*)(p.ws + OFF_WUP1), 1024, 1, tile); continue; } r -= 176;
        if (r < 176) { transpose_strip(p.in[5], 1024, (r / 4) * 64, (r % 4) * 256, (bf16_t*)(p.ws + OFF_WDN1), 2816, 2, tile); continue; } r -= 176;
        if (r < 224) { transpose_strip(p.in[8], 3584, (r / 14) * 64, (r % 14) * 256, (bf16_t*)(p.ws + OFF_WIN), 1024, 3, tile); continue; } r -= 224;
        if (r < 64) { transpose_strip(p.in[22], 1024, (r / 4) * 64, (r % 4) * 256, (bf16_t*)(p.ws + OFF_WOUT), 1024, 2, tile); continue; } r -= 64;
        if (r < 176) { transpose_strip(p.in[25], 2816, (r / 11) * 64, (r % 11) * 256, (bf16_t*)(p.ws + OFF_WUP2), 1024, 0, tile); continue; } r -= 176;
        if (r < 176) { transpose_strip(p.in[26], 2816, (r / 11) * 64, (r % 11) * 256, (bf16_t*)(p.ws + OFF_WUP2), 1024, 1, tile); continue; } r -= 176;
        transpose_strip(p.in[27], 1024, (r / 4) * 64, (r % 4) * 256, (bf16_t*)(p.ws + OFF_WDN2), 2816, 2, tile);
    }
}

__device__ void phase0_rot(const Params& p) {
    v2f* rot = (v2f*)(p.ws + OFF_ROT);
    for (int i = blockIdx.x * 512 + threadIdx.x; i < 8192 * 64; i += gridDim.x * 512) {
        const int pos = i >> 6, f = i & 63;
        const float inv = 1.0f / powf(10000.0f, (float)(2 * f) / 128.0f);
        const float ang = (float)pos * inv;
        float s, c; sincosf(ang, &s, &c);
        v2f cs; cs.x = c; cs.y = s;
        rot[i] = cs;
    }
}

__device__ __forceinline__ const float* x_row(const Params& p, int r) { return r < T_P ? p.in[0] + (size_t)r * 1024 : p.in[1] + (size_t)(r - T_P) * 1024; }
__device__ __forceinline__ void load_bf_row(const char* base, int lane, float (&v)[16]) {
#pragma unroll
    for (int i = 0; i < 4; ++i) { const u32x2 w = *(const u32x2*)(base + (lane * 4 + 256 * i) * 2); v[4 * i] = bflo(w.x); v[4 * i + 1] = bfhi(w.x); v[4 * i + 2] = bflo(w.y); v[4 * i + 3] = bfhi(w.y); }
}
__device__ __forceinline__ void store_bf_row(char* base, int lane, const float (&v)[16]) {
#pragma unroll
    for (int i = 0; i < 4; ++i) { u32x2 w; w.x = pack_bf(v[4 * i], v[4 * i + 1]); w.y = pack_bf(v[4 * i + 2], v[4 * i + 3]); *(u32x2*)(base + (lane * 4 + 256 * i) * 2) = w; }
}
__device__ __forceinline__ void load_f_row(const float* base, int lane, float (&v)[16]) {
#pragma unroll
    for (int i = 0; i < 4; ++i) { const f32x4 w = *(const f32x4*)(base + lane * 4 + 256 * i); v[4 * i] = w[0]; v[4 * i + 1] = w[1]; v[4 * i + 2] = w[2]; v[4 * i + 3] = w[3]; }
}
__device__ __forceinline__ float row_rs(const float (&v)[16]) { float ss = 0.f;
#pragma unroll
    for (int i = 0; i < 16; ++i) ss += v[i] * v[i];
    ss = wave_sum(ss); return rsqrtf(ss * (1.0f / 1024.0f) + 1e-6f); }

__device__ void row_phase(const Params& p, int mode, const float* g0p, const float* g1p, int rep = 1) {
    const int lane = threadIdx.x & 63, gw = blockIdx.x * 8 + (threadIdx.x >> 6), nw = gridDim.x * 8;
    float g0[16], g1[16];
    load_f_row(g0p, lane, g0);
    if (g1p) load_f_row(g1p, lane, g1);
    for (int rr = gw; rr < T_ALL * rep; rr += nw) {
        const int r = rr % T_ALL;
        char* slot = (char*)p.out + (size_t)r * 4096;
        float x[16]; load_f_row(x_row(p, r), lane, x);
        if (mode == 0) {
            const float rs = row_rs(x); float h[16];
#pragma unroll
            for (int i = 0; i < 16; ++i) h[i] = x[i] * rs * g0[i];
            store_bf_row(slot + 2048, lane, h);
        } else {
            float f[16]; load_bf_row(slot + 2048, lane, f);
            const float rs = row_rs(f);
            float d[16];
            if (mode >= 2) load_bf_row(slot, lane, d);
            const float sc = (mode == 2) ? 1.0f : 0.5f;
            if (mode == 3) {
#pragma unroll
                for (int i = 0; i < 4; ++i) { f32x4 w;
#pragma unroll
                    for (int j = 0; j < 4; ++j) w[j] = x[4 * i + j] + d[4 * i + j] + sc * f[4 * i + j] * rs * g0[4 * i + j];
                    *(f32x4*)(slot + (lane * 4 + 256 * i) * 4) = w; }
            } else {
                float xn[16];
#pragma unroll
                for (int i = 0; i < 16; ++i) { float b = sc * f[i] * rs * g0[i]; if (mode == 2) b += d[i]; d[i] = b; xn[i] = x[i] + b; }
                store_bf_row(slot, lane, d);
                const float rs2 = row_rs(xn); float h[16];
#pragma unroll
                for (int i = 0; i < 16; ++i) h[i] = xn[i] * rs2 * g1[i];
                store_bf_row(slot + 2048, lane, h);
            }
        }
    }
}

__device__ void filter_unit(const Params& p, int unit, LAS unsigned char* lds) {
    const int Lsel = unit >= 64 ? 1 : 0, L = Lsel ? 8192 : 4096, t0 = (Lsel ? unit - 64 : unit) * 64;
    LAS float* zs = (LAS float*)lds;
    LAS float* hA = zs + 64 * 33;
    LAS float* hB = hA + 64 * 65;
    LAS float* Ws = hB + 64 * 65;
    LAS bf16_t* h3b = (LAS bf16_t*)(Ws + 64 * 64);
    LAS bf16_t* w4t = h3b + 64 * 72;
    const int tid = threadIdx.x;
    const float* W1 = p.in[11]; const float* B1 = p.in[12]; const float* W2 = p.in[13]; const float* B2 = p.in[14];
    const float* W3 = p.in[15]; const float* B3 = p.in[16]; const float* W4 = p.in[17]; const float* FR = p.in[18];
    __syncthreads();
    if (tid < 64) {
        const int t = t0 + tid;
        zs[tid * 33] = (float)t / (float)(L - 1);
        const float w = 6.283185307179586f * (float)t / (float)L;
#pragma unroll 1
        for (int b = 0; b < 16; ++b) { const float fb = 1e-4f + (float)b * ((15.0f - 1e-4f) / 15.0f); const float a = fb * w; float s, c; sincosf(a, &s, &c);
            zs[tid * 33 + 1 + b] = c; zs[tid * 33 + 17 + b] = -s; }
    }
    for (int i = tid; i < 33 * 64; i += 512) Ws[i] = W1[i];
    __syncthreads();
    const int t = tid & 63, kg = tid >> 6;
#pragma unroll 1
    for (int layer = 0; layer < 3; ++layer) {
        const LAS float* hin = layer == 0 ? zs : (layer == 1 ? hA : hB);
        LAS float* hout = layer == 1 ? hB : hA;
        const int istr = layer == 0 ? 33 : 65, nin = layer == 0 ? 33 : 64;
        const float* Bp = layer == 0 ? B1 : (layer == 1 ? B2 : B3);
        float a[8];
#pragma unroll
        for (int i = 0; i < 8; ++i) a[i] = Bp[kg * 8 + i];
#pragma unroll 4
        for (int j = 0; j < nin; ++j) { const float hv = hin[t * istr + j];
            const f32x4 w0 = *(const LAS f32x4*)(Ws + j * 64 + kg * 8), w1 = *(const LAS f32x4*)(Ws + j * 64 + kg * 8 + 4);
            a[0] += hv * w0[0]; a[1] += hv * w0[1]; a[2] += hv * w0[2]; a[3] += hv * w0[3]; a[4] += hv * w1[0]; a[5] += hv * w1[1]; a[6] += hv * w1[2]; a[7] += hv * w1[3]; }
        __syncthreads();
        const float* Wn = layer == 0 ? W2 : W3;
        if (layer < 2) for (int i = tid; i < 64 * 64; i += 512) Ws[i] = Wn[i];
#pragma unroll
        for (int i = 0; i < 8; ++i) { const float hv = sinf(FR[kg * 8 + i] * a[i]); if (layer < 2) hout[t * 65 + kg * 8 + i] = hv; else h3b[t * 72 + kg * 8 + i] = f2bf(hv); }
        __syncthreads();
    }
    const int wid = tid >> 6, lane = tid & 63, lr = lane & 15, lq = lane >> 4;
    bf16x8 afr[4][2];
#pragma unroll
    for (int mt = 0; mt < 4; ++mt)
#pragma unroll
        for (int ks = 0; ks < 2; ++ks) afr[mt][ks] = *(const LAS bf16x8*)(h3b + (16 * mt + lr) * 72 + 32 * ks + lq * 8);
    __half* hraw = (__half*)(p.ws + OFF_HRAW) + (Lsel ? (size_t)2048 * 4096 : (size_t)0);
#pragma unroll 1
    for (int quarter = 0; quarter < 4; ++quarter) {
#pragma unroll 4
        for (int i = 0; i < 64; ++i) { const int k = i, col = tid;
            w4t[col * 68 + k] = f2bf(W4[(size_t)k * 2048 + quarter * 512 + col]); }
        __syncthreads();
        f32x4 acc[4][4];
#pragma unroll
        for (int mt = 0; mt < 4; ++mt)
#pragma unroll
            for (int nt = 0; nt < 4; ++nt) acc[mt][nt] = (f32x4){0.f, 0.f, 0.f, 0.f};
#pragma unroll
        for (int nt = 0; nt < 4; ++nt)
#pragma unroll
            for (int ks = 0; ks < 2; ++ks) { const LAS bf16_t* bp = w4t + (64 * wid + 16 * nt + lr) * 68 + 32 * ks + lq * 8;
                const u32x2 b0 = *(const LAS u32x2*)bp, b1 = *(const LAS u32x2*)(bp + 4);
                u32x4 bw; bw.x = b0.x; bw.y = b0.y; bw.z = b1.x; bw.w = b1.y;
                const bf16x8 bfr = __builtin_bit_cast(bf16x8, bw);
#pragma unroll
                for (int mt = 0; mt < 4; ++mt) acc[mt][nt] = __builtin_amdgcn_mfma_f32_16x16x32_bf16(afr[mt][ks], bfr, acc[mt][nt], 0, 0, 0); }
#pragma unroll
        for (int nt = 0; nt < 4; ++nt) { const int col = quarter * 512 + 64 * wid + 16 * nt + lr, c = col & 511;
            const float ad = 3.0701134573253944f + (float)c * ((15.350567286626972f - 3.0701134573253944f) / 511.0f);
#pragma unroll
            for (int mt = 0; mt < 4; ++mt) { const int tt = t0 + 16 * mt + lq * 4;
                __half2 h01 = __floats2half2_rn(acc[mt][nt][0] * expf(-((float)(tt + 0) / (float)(L - 1)) * ad), acc[mt][nt][1] * expf(-((float)(tt + 1) / (float)(L - 1)) * ad));
                __half2 h23 = __floats2half2_rn(acc[mt][nt][2] * expf(-((float)(tt + 2) / (float)(L - 1)) * ad), acc[mt][nt][3] * expf(-((float)(tt + 3) / (float)(L - 1)) * ad));
                u32x2 w; w.x = __builtin_bit_cast(unsigned, h01); w.y = __builtin_bit_cast(unsigned, h23);
                *(u32x2*)(hraw + (size_t)col * L + tt) = w; } }
        __syncthreads();
    }
}
__device__ __forceinline__ float ldbf(const bf16_t* p) { return bf2f(*p); }
template <int NT, int L>
__device__ __forceinline__ void stage_conv_row(const bf16_t* row, int lt, float w0, float w1, float w2, float b, LAS unsigned short* stage) {
#pragma unroll
    for (int i = 0; i < L / 8 / NT; ++i) {
        const int tb = (lt + i * NT) * 8;
        const u32x4 w = *(const u32x4*)(row + tb);
        const unsigned short lo = row[tb > 0 ? tb - 1 : 0], hi = row[tb + 8 < L ? tb + 8 : L - 1];
        float u[10];
        u[0] = tb > 0 ? bf2f(lo) : 0.f; u[9] = tb + 8 < L ? bf2f(hi) : 0.f;
        u[1] = bflo(w.x); u[2] = bfhi(w.x); u[3] = bflo(w.y); u[4] = bfhi(w.y); u[5] = bflo(w.z); u[6] = bfhi(w.z); u[7] = bflo(w.w); u[8] = bfhi(w.w);
        float r[8];
#pragma unroll
        for (int k = 0; k < 8; ++k) r[k] = u[k] * w0 + u[k + 1] * w1 + u[k + 2] * w2 + b;
        u32x4 o;
        o.x = __builtin_bit_cast(unsigned, __floats2half2_rn(r[0], r[1])); o.y = __builtin_bit_cast(unsigned, __floats2half2_rn(r[2], r[3]));
        o.z = __builtin_bit_cast(unsigned, __floats2half2_rn(r[4], r[5])); o.w = __builtin_bit_cast(unsigned, __floats2half2_rn(r[6], r[7]));
        *(LAS u32x4*)(stage + tb) = o;
    }
}

template <class C>
__device__ void hyena_channel(const Params& p, LAS v2f* buf, LAS float* red, LAS unsigned short* stage, unsigned* ks, unsigned* zs, int lt_in, int Lsel, int c, bool do_store = true) {
    constexpr int N = C::N, L = N / 2, S1 = C::S1, NT = C::NT, NW = NT / 64;
    const bf16_t* CT = (const bf16_t*)(p.ws + OFF_CT);
    const float* SW = p.in[9]; const float* SB = p.in[10];
    const __half* hraw = (const __half*)(p.ws + OFF_HRAW) + (Lsel ? (size_t)2048 * 4096 : (size_t)0);
    bf16_t* ctw = (bf16_t*)(p.ws + OFF_CT);
#pragma unroll 1
    for (int o = 0; o < 2; ++o) {
#pragma unroll 1
        for (int st = 0; st < 3; ++st) {
            const int bb0 = Lsel * 4 + (st == 2 ? 2 : 0);
            const int rb0 = row_base(bb0), rb1 = row_base(bb0 + 1);
            const bf16_t* ct0 = CT + (size_t)rb0 * 2048; const bf16_t* ct1 = CT + (size_t)rb1 * 2048;
            unsigned* zp = zs + (st == 2 ? 16 * NT : 0);
            {
                const int lt = opaque_i(lt_in), lane = lt & 63, lw = lt >> 6;
                v2f v[32];
                if (st == 0) {
                    const __half* hf = hraw + (size_t)(o * 1024 + c) * L; const __half* hb = hf + (size_t)512 * L;
                    float sf = 0.f, sb = 0.f;
                    __half hr[32];
#pragma unroll
                    for (int j = 0; j < 16; ++j) hr[j] = hf[lt + j * S1];
#pragma unroll
                    for (int j = 16; j < 32; ++j) { const int idx = lt + j * S1; hr[j] = hb[N - idx == L ? 0 : N - idx]; }
                    __builtin_amdgcn_sched_barrier(0);
#pragma unroll
                    for (int j = 0; j < 16; ++j) { const float x = __half2float(hr[j]); v[j].x = x; v[j].y = 0.f; sf += fabsf(x); }
#pragma unroll
                    for (int j = 16; j < 32; ++j) { const int idx = lt + j * S1; const float x = __half2float(hr[j]); sb += fabsf(x);
                        v[j].x = (idx == L) ? 0.f : x; v[j].y = 0.f; }
                    sf = wave_sum(sf); sb = wave_sum(sb);
                    if (lane == 0) { red[lw * 2] = sf; red[lw * 2 + 1] = sb; }
                    __syncthreads();
                    float tf = 0.f, tb = 0.f;
#pragma unroll
                    for (int w = 0; w < NW; ++w) { tf += red[w * 2]; tb += red[w * 2 + 1]; }
                    const float isf = 1.0f / tf, isb = 1.0f / tb;
#pragma unroll
                    for (int j = 0; j < 16; ++j) v[j].x *= isf;
#pragma unroll
                    for (int j = 16; j < 32; ++j) v[j].x *= isb;
                } else {
                    if (o == 0) {
                        const float w0 = SW[c], w1 = SW[1536 + c], w2 = SW[3072 + c], b = SB[c];
                        stage_conv_row<NT, L>(ct0 + (size_t)c * L, lt, w0, w1, w2, b, stage);
                        __syncthreads();
#pragma unroll
                        for (int j = 0; j < 16; ++j) v[j].x = __half2float(__ushort_as_half(stage[lt + j * S1]));
                        __syncthreads();
                        stage_conv_row<NT, L>(ct1 + (size_t)c * L, lt, w0, w1, w2, b, stage);
                        __syncthreads();
#pragma unroll
                        for (int j = 0; j < 16; ++j) v[j].y = __half2float(__ushort_as_half(stage[lt + j * S1]));
                    } else {
#pragma unroll
                        for (int j = 0; j < 16; ++j) { const float2 zf = __half22float2(__builtin_bit_cast(__half2, zp[j * NT + lt])); v[j].x = zf.x; v[j].y = zf.y; }
                    }
#pragma unroll
                    for (int j = 16; j < 32; ++j) { v[j].x = 0.f; v[j].y = 0.f; }
                }
                pass1_fwd<C>(v, lt, buf);
            }
            __syncthreads();
            pass2<C, false>(opaque_i(lt_in), buf);
            __syncthreads();
            if (st == 0) { pass3_filter<C>(opaque_i(lt_in), buf, ks, p.in[19][o * 512 + c]); __syncthreads(); continue; }
            pass3_fused<C>(opaque_i(lt_in), buf, ks);
            __syncthreads();
            pass2<C, true>(opaque_i(lt_in), buf);
            __syncthreads();
            {
                const int lt = opaque_i(lt_in);
                const int ch = (o == 0 ? 512 : 1024) + c;
                const float w0 = SW[ch], w1 = SW[1536 + ch], w2 = SW[3072 + ch], b = SB[ch];
                v2f v[32];
                pass1_inv<C>(v, lt, buf);
                float yx[16], yy[16];
#pragma unroll
                for (int n1 = 0; n1 < 16; ++n1) { const v2f y = v[brev_c(n1, 5)] * (1.0f / (float)N); yx[n1] = y.x; yy[n1] = y.y; }
                stage_conv_row<NT, L>(ct0 + (size_t)ch * L, lt, w0, w1, w2, b, stage);
                __syncthreads();
#pragma unroll
                for (int n1 = 0; n1 < 16; ++n1) yx[n1] *= __half2float(__ushort_as_half(stage[lt + n1 * S1]));
                __syncthreads();
                stage_conv_row<NT, L>(ct1 + (size_t)ch * L, lt, w0, w1, w2, b, stage);
                __syncthreads();
#pragma unroll
                for (int n1 = 0; n1 < 16; ++n1) yy[n1] *= __half2float(__ushort_as_half(stage[lt + n1 * S1]));
#pragma unroll
                for (int n1 = 0; n1 < 16; ++n1) { const int t = lt + n1 * S1;
                    if (o == 0) { zp[n1 * NT + lt] = __builtin_bit_cast(unsigned, __floats2half2_rn(yx[n1], yy[n1])); }
                    else if (do_store) { ctw[(size_t)rb0 * 2048 + (size_t)c * L + t] = f2bf(yx[n1]); ctw[(size_t)rb1 * 2048 + (size_t)c * L + t] = f2bf(yy[n1]); } }
            }
            __syncthreads();
        }
    }
}

__device__ __forceinline__ char* sbuf_addr(const Params& p, int unit, int e, int dp) { return (char*)p.out + ((size_t)unit * 32 + (e >> 2)) * 4096 + 2048 + (e & 3) * 512 + dp * 2; }

__device__ void ret_state_unit(const Params& p, int unit, LAS unsigned char* lds) {
    const int h = unit & 3, gc = unit >> 2, r0 = gc * 128; int rb, L; row_info(r0, rb, L); const int t0 = r0 - rb;
    const bf16_t* Kk = (const bf16_t*)(p.ws + OFF_K) + (size_t)r0 * 512 + h * 128;
    const bf16_t* vT = (const bf16_t*)(p.ws + OFF_CT) + (size_t)rb * 2048 + (size_t)(1536 + h * 128) * L + t0;
    const int tid = opaque_i(threadIdx.x), wid = tid >> 6, lane = tid & 63, lr = lane & 15, lq = lane >> 4;
    LAS unsigned char* lK = lds; LAS unsigned char* lV = lds + 34816;
    {
        u32x4 rk[4], rv[4];
#pragma unroll
        for (int i = 0; i < 4; ++i) { const int q = tid + i * 512, row = q >> 4, c16 = q & 15;
            const int jr = q & 127, dc = q >> 7;
            rk[i] = *(const u32x4*)(Kk + (size_t)jr * 512 + dc * 8); rv[i] = *(const u32x4*)(vT + (size_t)row * L + c16 * 8); }
#pragma unroll
        for (int i = 0; i < 4; ++i) { const int q = tid + i * 512, row = q >> 4, c16 = q & 15;
            const int jr = q & 127, dc = q >> 7;
            LAS unsigned short* kt = (LAS unsigned short*)(lK + (dc * 8) * 272 + jr * 2);
            kt[0 * 136] = (unsigned short)(rk[i].x & 0xffffu); kt[1 * 136] = (unsigned short)(rk[i].x >> 16);
            kt[2 * 136] = (unsigned short)(rk[i].y & 0xffffu); kt[3 * 136] = (unsigned short)(rk[i].y >> 16);
            kt[4 * 136] = (unsigned short)(rk[i].z & 0xffffu); kt[5 * 136] = (unsigned short)(rk[i].z >> 16);
            kt[6 * 136] = (unsigned short)(rk[i].w & 0xffffu); kt[7 * 136] = (unsigned short)(rk[i].w >> 16);
            *(LAS u32x4*)(lV + row * 272 + c16 * 16) = rv[i]; }
    }
    __syncthreads();
    const bool bwd = wid >= 4;
    const float lg = bwd ? p.in[21][h] : p.in[20][h];
    f32x4 acc[2][8];
#pragma unroll
    for (int a = 0; a < 2; ++a)
#pragma unroll
        for (int b = 0; b < 8; ++b) acc[a][b] = (f32x4){0.f, 0.f, 0.f, 0.f};
#pragma unroll
    for (int ks = 0; ks < 4; ++ks) {
        const int j0 = 32 * ks + lq * 8;
        float wk[8];
#pragma unroll
        for (int i = 0; i < 8; ++i) { const int j = j0 + i; wk[i] = __expf(lg * (float)(bwd ? j : 127 - j)); }
        bf16x8 a[2];
#pragma unroll
        for (int mt = 0; mt < 2; ++mt) { const int d = (32 * wid + 16 * mt + lr) & 127;
            const u32x4 raw = *(const LAS u32x4*)(lK + d * 272 + j0 * 2);
            u32x4 w;
            w.x = pack_bf(bflo(raw.x) * wk[0], bfhi(raw.x) * wk[1]); w.y = pack_bf(bflo(raw.y) * wk[2], bfhi(raw.y) * wk[3]);
            w.z = pack_bf(bflo(raw.z) * wk[4], bfhi(raw.z) * wk[5]); w.w = pack_bf(bflo(raw.w) * wk[6], bfhi(raw.w) * wk[7]);
            a[mt] = __builtin_bit_cast(bf16x8, w); }
#pragma unroll
        for (int nt = 0; nt < 8; ++nt) { const int e = 16 * nt + lr;
            const bf16x8 b = *(const LAS bf16x8*)(lV + e * 272 + j0 * 2);
#pragma unroll
            for (int mt = 0; mt < 2; ++mt) acc[mt][nt] = __builtin_amdgcn_mfma_f32_16x16x32_bf16(a[mt], b, acc[mt][nt], 0, 0, 0); }
        __builtin_amdgcn_sched_barrier(0);
    }
#pragma unroll
    for (int mt = 0; mt < 2; ++mt)
#pragma unroll
        for (int nt = 0; nt < 8; ++nt) { const int dp = 32 * wid + 16 * mt + lq * 4, e = 16 * nt + lr;
            u32x2 w; w.x = pack_bf(acc[mt][nt][0], acc[mt][nt][1]); w.y = pack_bf(acc[mt][nt][2], acc[mt][nt][3]);
            *(u32x2*)sbuf_addr(p, unit, e, dp) = w; }
    __syncthreads();
}

__device__ void ret_scan(const Params& p) {
#pragma unroll 1
    for (int gid = blockIdx.x * 512 + threadIdx.x; gid < 131072; gid += gridDim.x * 512) {
    const int dg = gid & 31, e = (gid >> 5) & 127, h = (gid >> 12) & 3, bb = gid >> 14;
    const bool bwd = dg >= 16;
    const float gC = __expf(128.0f * (bwd ? p.in[21][h] : p.in[20][h]));
    const int nc = bb < 4 ? 32 : 64, gc0 = row_base(bb) / 128;
    float run[8];
#pragma unroll
    for (int i = 0; i < 8; ++i) run[i] = 0.f;
#pragma unroll 1
    for (int it = 0; it < nc; it += 4) {
        u32x4 s[4]; char* ad[4];
#pragma unroll
        for (int q = 0; q < 4; ++q) { const int n = bwd ? (nc - 1 - it - q) : (it + q); ad[q] = sbuf_addr(p, (gc0 + n) * 4 + h, e, dg * 8); s[q] = *(const u32x4*)ad[q]; }
#pragma unroll
        for (int q = 0; q < 4; ++q) {
            u32x4 w; w.x = pack_bf(run[0], run[1]); w.y = pack_bf(run[2], run[3]); w.z = pack_bf(run[4], run[5]); w.w = pack_bf(run[6], run[7]);
            *(u32x4*)ad[q] = w;
            run[0] = gC * run[0] + bflo(s[q].x); run[1] = gC * run[1] + bfhi(s[q].x); run[2] = gC * run[2] + bflo(s[q].y); run[3] = gC * run[3] + bfhi(s[q].y);
            run[4] = gC * run[4] + bflo(s[q].z); run[5] = gC * run[5] + bfhi(s[q].z); run[6] = gC * run[6] + bflo(s[q].w); run[7] = gC * run[7] + bfhi(s[q].w);
        }
    }
    }
}

__device__ void ret_out_unit(const Params& p, int unit, LAS unsigned char* lds, bool do_store = true) {
    const int h = unit & 3, gc = unit >> 2, r0 = gc * 128; int rb, L; row_info(r0, rb, L); const int t0 = r0 - rb;
    bf16_t* Q = (bf16_t*)(p.ws + OFF_Q) + (size_t)r0 * 512 + h * 128;
    const bf16_t* Kk = (const bf16_t*)(p.ws + OFF_K) + (size_t)r0 * 512 + h * 128;
    const bf16_t* SG = (const bf16_t*)(p.ws + OFF_SG) + (size_t)r0 * 512 + h * 128;
    const bf16_t* vT = (const bf16_t*)(p.ws + OFF_CT) + (size_t)rb * 2048 + (size_t)(1536 + h * 128) * L + t0;
    const int tid = opaque_i(threadIdx.x), wid = tid >> 6, lane = tid & 63, lr = lane & 15, lq = lane >> 4;
    const float lgf = p.in[20][h], lgb = p.in[21][h];
    LAS unsigned char* lK = lds;
    LAS unsigned char* lV = lds + 34816;
    LAS unsigned char* lR = lds + 69632;
    bf16x8 qa[4];
    {
        u32x4 rr[8];
#pragma unroll
        for (int i = 0; i < 8; ++i) { const int q = tid + i * 512, row = q >> 5, c16 = q & 31; rr[i] = *(const u32x4*)sbuf_addr(p, unit, row, c16 * 8); }
#pragma unroll
        for (int i = 0; i < 8; ++i) { const int q = tid + i * 512, row = q >> 5, c16 = q & 31; *(LAS u32x4*)(lR + row * 528 + c16 * 16) = rr[i]; }
    }
    {
        u32x4 rk[4], rv[4];
#pragma unroll
        for (int i = 0; i < 4; ++i) { const int q = tid + i * 512, row = q >> 4, c16 = q & 15;
            rk[i] = *(const u32x4*)(Kk + (size_t)row * 512 + c16 * 8); rv[i] = *(const u32x4*)(vT + (size_t)row * L + c16 * 8); }
#pragma unroll
        for (int ks = 0; ks < 4; ++ks) qa[ks] = *(const bf16x8*)(Q + (size_t)(16 * wid + lr) * 512 + 32 * ks + lq * 8);
#pragma unroll
        for (int i = 0; i < 4; ++i) { const int q = tid + i * 512, row = q >> 4, c16 = q & 15;
            *(LAS u32x4*)(lK + row * 272 + c16 * 16) = rk[i]; *(LAS u32x4*)(lV + row * 272 + c16 * 16) = rv[i]; }
    }
    __syncthreads();
    f32x4 s[8];
#pragma unroll
    for (int nt = 0; nt < 8; ++nt) { s[nt] = (f32x4){0.f, 0.f, 0.f, 0.f};
#pragma unroll
        for (int ks = 0; ks < 4; ++ks) { const bf16x8 b = *(const LAS bf16x8*)(lK + (16 * nt + lr) * 272 + (32 * ks + lq * 8) * 2);
            s[nt] = __builtin_amdgcn_mfma_f32_16x16x32_bf16(qa[ks], b, s[nt], 0, 0, 0); }
        __builtin_amdgcn_sched_barrier(0); }
    __syncthreads();
    LAS bf16_t* Pw = (LAS bf16_t*)lK + wid * (16 * 136);
#pragma unroll
    for (int nt = 0; nt < 8; ++nt)
#pragma unroll
        for (int r = 0; r < 4; ++r) { const int i = 16 * wid + lq * 4 + r, j = 16 * nt + lr, diff = i - j;
            const float D = diff >= 0 ? __expf(lgf * (float)diff) : __expf(lgb * (float)(-diff));
            Pw[(lq * 4 + r) * 136 + j] = f2bf(s[nt][r] * D); }
    __syncthreads();
    bf16x8 pa[4];
#pragma unroll
    for (int ks = 0; ks < 4; ++ks) pa[ks] = *(const LAS bf16x8*)(Pw + lr * 136 + 32 * ks + lq * 8);
    f32x4 o1[8], of[8], ob[8];
#pragma unroll
    for (int nt = 0; nt < 8; ++nt) { const int e = 16 * nt + lr;
        o1[nt] = (f32x4){0.f, 0.f, 0.f, 0.f}; of[nt] = o1[nt]; ob[nt] = o1[nt];
#pragma unroll
        for (int ks = 0; ks < 4; ++ks) {
            const bf16x8 bv = *(const LAS bf16x8*)(lV + e * 272 + (32 * ks + lq * 8) * 2);
            o1[nt] = __builtin_amdgcn_mfma_f32_16x16x32_bf16(pa[ks], bv, o1[nt], 0, 0, 0);
            const bf16x8 bf = *(const LAS bf16x8*)(lR + e * 528 + (32 * ks + lq * 8) * 2);
            of[nt] = __builtin_amdgcn_mfma_f32_16x16x32_bf16(qa[ks], bf, of[nt], 0, 0, 0);
            const bf16x8 bb = *(const LAS bf16x8*)(lR + e * 528 + 256 + (32 * ks + lq * 8) * 2);
            ob[nt] = __builtin_amdgcn_mfma_f32_16x16x32_bf16(qa[ks], bb, ob[nt], 0, 0, 0); }
        __builtin_amdgcn_sched_barrier(0); }
    __syncthreads();
    {
        u32x4 rg[4];
#pragma unroll
        for (int i = 0; i < 4; ++i) { const int q = tid + i * 512, row = q >> 4, c16 = q & 15; rg[i] = *(const u32x4*)(SG + (size_t)row * 512 + c16 * 8); }
#pragma unroll
        for (int i = 0; i < 4; ++i) { const int q = tid + i * 512, row = q >> 4, c16 = q & 15; *(LAS u32x4*)(lK + row * 272 + c16 * 16) = rg[i]; }
    }
    __syncthreads();
#pragma unroll
    for (int r = 0; r < 4; ++r) { const int i = 16 * wid + lq * 4 + r;
        const float wqf = __expf(lgf * (float)(i + 1)), wqb = __expf(lgb * (float)(128 - i));
        float ov[8]; float ss = 0.f;
#pragma unroll
        for (int nt = 0; nt < 8; ++nt) { const float o = o1[nt][r] + wqf * of[nt][r] + wqb * ob[nt][r]; ov[nt] = o; ss += o * o; }
        ss += __shfl_xor(ss, 1); ss += __shfl_xor(ss, 2); ss += __shfl_xor(ss, 4); ss += __shfl_xor(ss, 8);
        const float rs = rsqrtf(ss * (1.0f / 128.0f) + 1e-6f);
#pragma unroll
        for (int nt = 0; nt < 8; ++nt) { const int e = 16 * nt + lr; const float g = bf2f(*(const LAS bf16_t*)(lK + i * 272 + e * 2));
            *(LAS bf16_t*)(lV + i * 272 + e * 2) = f2bf(ov[nt] * rs * g); }
        __builtin_amdgcn_sched_barrier(0); }
    __syncthreads();
    if (do_store) {
#pragma unroll
        for (int i = 0; i < 4; ++i) { const int q = tid + i * 512, row = q >> 4, c16 = q & 15;
            *(u32x4*)(Q + (size_t)row * 512 + c16 * 8) = *(const LAS u32x4*)(lV + row * 272 + c16 * 16); }
    }
    __syncthreads();
}

__device__ void yh_transpose_tile(const Params& p, int tile, LAS bf16_t* lt_) {
    const int ctile = tile & 7, ttile = tile >> 3;
    const int r0 = ttile * 256; int rb, L; row_info(r0, rb, L);
    const bf16_t* src = (const bf16_t*)(p.ws + OFF_CT) + (size_t)rb * 2048 + (size_t)(ctile * 64) * L + (r0 - rb);
    bf16_t* dst = (bf16_t*)(p.ws + OFF_KT) + (size_t)r0 * 512 + ctile * 64;
    const int tid = opaque_i(threadIdx.x);
    u32x4 w[4];
#pragma unroll
    for (int i = 0; i < 4; ++i) { const int q = tid + i * 512, a = q >> 5, b8 = (q & 31) * 8; w[i] = *(const u32x4*)(src + (size_t)a * L + b8); }
#pragma unroll
    for (int i = 0; i < 4; ++i) { const int q = tid + i * 512, a = q >> 5, b8 = (q & 31) * 8;
        lt_[(b8 + 0) * 66 + a] = (bf16_t)(w[i].x & 0xffffu); lt_[(b8 + 1) * 66 + a] = (bf16_t)(w[i].x >> 16);
        lt_[(b8 + 2) * 66 + a] = (bf16_t)(w[i].y & 0xffffu); lt_[(b8 + 3) * 66 + a] = (bf16_t)(w[i].y >> 16);
        lt_[(b8 + 4) * 66 + a] = (bf16_t)(w[i].z & 0xffffu); lt_[(b8 + 5) * 66 + a] = (bf16_t)(w[i].z >> 16);
        lt_[(b8 + 6) * 66 + a] = (bf16_t)(w[i].w & 0xffffu); lt_[(b8 + 7) * 66 + a] = (bf16_t)(w[i].w >> 16); }
    __syncthreads();
#pragma unroll
    for (int i = 0; i < 4; ++i) { const int q = tid + i * 512, a = q >> 3, b8 = (q & 7) * 8;
        u32x4 o;
        o.x = (unsigned)lt_[a * 66 + b8 + 0] | ((unsigned)lt_[a * 66 + b8 + 1] << 16); o.y = (unsigned)lt_[a * 66 + b8 + 2] | ((unsigned)lt_[a * 66 + b8 + 3] << 16);
        o.z = (unsigned)lt_[a * 66 + b8 + 4] | ((unsigned)lt_[a * 66 + b8 + 5] << 16); o.w = (unsigned)lt_[a * 66 + b8 + 6] | ((unsigned)lt_[a * 66 + b8 + 7] << 16);
        *(u32x4*)(dst + (size_t)a * 512 + b8) = o; }
    __syncthreads();
}

#define XB_TMO      128
#define XB_XCNT(j)  (256  + 64 * (j))
#define XB_XSUB(j)  (1280 + 64 * (j))
#define XB_XGEN(j)  (2304 + 64 * (j))
#define XB_TOP      3328
#define XB_TOPGEN   3392
#define XCD_BAR_WORDS 3456
#define XB_SPIN_CAP (1u << 18)

__device__ __forceinline__ unsigned xb_ld(unsigned* p)              { return __hip_atomic_load(p, __ATOMIC_RELAXED, __HIP_MEMORY_SCOPE_AGENT); }
__device__ __forceinline__ unsigned xb_add(unsigned* p, unsigned v) { return __hip_atomic_fetch_add(p, v, __ATOMIC_RELAXED, __HIP_MEMORY_SCOPE_AGENT); }
__device__ __forceinline__ unsigned xb_xcc_id() { return (unsigned)__builtin_amdgcn_s_getreg((3 << 11) | 20) & 0xFu; }
#define XB_SPIN(cond, bar) do { unsigned _sp = 0; while (cond) { __builtin_amdgcn_s_sleep(1); \
    if ((++_sp & 255u) == 0u) { if (xb_ld(&(bar)[XB_TMO])) break; if (_sp > XB_SPIN_CAP) { atomicAdd(&(bar)[XB_TMO], 1u); break; } } } } while (0)

struct XcdBarrier {
    unsigned* bar; unsigned x;
    volatile LAS unsigned* st;
};

__device__ __forceinline__ XcdBarrier xcd_barrier_post(unsigned* bar, volatile LAS unsigned* st) {
    XcdBarrier b; b.bar = bar; b.x = xb_xcc_id(); b.st = st;
    if (threadIdx.x == 0) (void)xb_add(&bar[XB_XCNT(b.x)], 1u);
    return b;
}
__device__ __forceinline__ void xcd_barrier_complete(unsigned* bar, unsigned x, unsigned& nloc, unsigned& nx) {
    const unsigned G = gridDim.x * gridDim.y * gridDim.z;
    unsigned sum, cnt, mine, sp = 0u;
    for (;;) {
        sum = 0u; cnt = 0u; mine = 0u;
#pragma unroll
        for (unsigned j = 0; j < 16; ++j) { const unsigned c = xb_ld(&bar[XB_XCNT(j)]); sum += c; cnt += (c > 0u) ? 1u : 0u; mine = (j == x) ? c : mine; }
        if (sum == G) break;
        __builtin_amdgcn_s_sleep(1);
        if ((++sp & 255u) == 0u) { if (xb_ld(&bar[XB_TMO])) break; if (sp > XB_SPIN_CAP) { atomicAdd(&bar[XB_TMO], 1u); break; } }
    }
    nloc = mine > 0u ? mine : 1u; nx = cnt > 0u ? cnt : 1u;
}

__device__ __forceinline__ void xcd_barrier(const XcdBarrier& b) {
    asm volatile("s_waitcnt vmcnt(0)" ::: "memory");
    __syncthreads();
    if (threadIdx.x == 0) {
        unsigned* bar = b.bar;
        __builtin_amdgcn_s_waitcnt(0);
        unsigned nloc = b.st[0], nx = b.st[1];
        if (nloc == 0u) { xcd_barrier_complete(bar, b.x, nloc, nx); b.st[0] = nloc; b.st[1] = nx; }
        const unsigned old = xb_add(&bar[XB_XSUB(b.x)], 1u);
        const unsigned gen = old / nloc;
        if (old + 1u == (gen + 1u) * nloc) {
            __builtin_amdgcn_fence(__ATOMIC_RELEASE, "agent");
            asm volatile("s_waitcnt vmcnt(0)" ::: "memory");
            const unsigned og = xb_add(&bar[XB_TOP], 1u);
            const unsigned tg = og / nx;
            if (og + 1u == (tg + 1u) * nx) xb_add(&bar[XB_TOPGEN], 1u);
            else XB_SPIN(xb_ld(&bar[XB_TOPGEN]) == tg, bar);
            __builtin_amdgcn_fence(__ATOMIC_ACQUIRE, "agent");
            xb_add(&bar[XB_XGEN(b.x)], 1u);
            asm volatile("s_waitcnt vmcnt(0)" ::: "memory");
        } else {
            XB_SPIN(xb_ld(&bar[XB_XGEN(b.x)]) == gen, bar);
            __builtin_amdgcn_fence(__ATOMIC_ACQUIRE, "agent");
            asm volatile("s_waitcnt vmcnt(0)" ::: "memory");
        }
    }
    __syncthreads();
}


__device__ __attribute__((noinline)) void xcd_barrier_call(unsigned* bar, unsigned x, volatile LAS unsigned* st) { XcdBarrier b; b.bar = bar; b.x = x; b.st = st; xcd_barrier(b); }

typedef FftCfg<32, 32, 16, 512> CfgBig;
typedef FftCfg<32, 16, 16, 256> CfgSmall;

#define PHASE_SYNC() do { if (ph_hi - ph_lo > 1) xcd_barrier_call(xb.bar, xb.x, xb.st); } while (0)
#ifndef HY_REP
#define HY_REP 1
#endif
#ifndef DUP_MASK
#define DUP_MASK 0
#endif
#ifndef PHASE_MASK
#define PHASE_MASK 0x1fff
#endif
#define RUN(ph) (((PHASE_MASK >> (ph)) & 1) && ph_lo <= (ph) && (ph) < ph_hi)

__global__ void __launch_bounds__(512, 2) hybrid_forward(Params p) {
    cg::grid_group grid = cg::this_grid();
    extern __shared__ __attribute__((aligned(16))) unsigned char smem[];
    LAS unsigned char* lds = (LAS unsigned char*)smem;
    const int ph_lo = p.ph_lo, ph_hi = p.ph_hi;
    const int tid = threadIdx.x;
    bf16_t* slotB = (bf16_t*)((char*)p.out + 2048);
    pg8::StaticOrder S;
    volatile LAS unsigned* xb_words = (volatile LAS unsigned*)(lds + SMEM_BYTES);
    if (tid < 4) xb_words[tid] = 0u;
    __syncthreads();
    XcdBarrier xb = xcd_barrier_post((unsigned*)(p.ws + OFF_BAR), xb_words);

    if (RUN(0)) { auto phf = [&]() {
        phase0_transposes(p, (LAS float*)lds);
        phase0_rot(p);
        for (int u = blockIdx.x; u < 192 * REP_FILT; u += gridDim.x) filter_unit(p, u % 192, lds);
        row_phase(p, 0, p.in[2], nullptr, REP_ROW0);
    }; phf(); if ((DUP_MASK >> 0) & 1) phf(); }
    if (ph_lo < 1 && ph_hi > 1) grid.sync();
    if (RUN(1)) { auto phf = [&]() {
        pg8::Gemm g{slotB, (const bf16_t*)(p.ws + OFF_WUP1), T_ALL, 5632, 1024, 2048, 1024, 1 << 30, 0l};
        S.init(g.M, g.N, gridDim.x, blockIdx.x);
        pg8::gemm_phase(lds, g, S, pg8::EpiSwiglu{(bf16_t*)(p.ws + OFF_G), 2816});
    }; phf(); if ((DUP_MASK >> 1) & 1) phf(); }
    if (ph_lo < 2 && ph_hi > 2) PHASE_SYNC();
    if (RUN(2)) { auto phf = [&]() {
        pg8::Gemm g{(const bf16_t*)(p.ws + OFF_G), (const bf16_t*)(p.ws + OFF_WDN1), T_ALL, 1024, 2816, 2816, 2816, 1 << 30, 0l};
        S.init(g.M, g.N, gridDim.x, blockIdx.x);
        pg8::gemm_phase(lds, g, S, pg8::EpiBf16{slotB, 2048});
    }; phf(); if ((DUP_MASK >> 2) & 1) phf(); }
    if (ph_lo < 3 && ph_hi > 3) { PHASE_SYNC();
#pragma unroll 1
        for (int rep = 0; rep < EXTRA_SYNCS; ++rep) xcd_barrier_call(xb.bar, xb.x, xb.st); }
    if (RUN(3)) { auto phf = [&]() { row_phase(p, 1, p.in[6], p.in[7]); }; phf(); if ((DUP_MASK >> 3) & 1) phf(); }
    if (ph_lo < 4 && ph_hi > 4) PHASE_SYNC();
    if (RUN(4)) { auto phf = [&]() {
        {
            pg8::Gemm g{(const bf16_t*)(p.ws + OFF_WIN), slotB, 2048, T_ALL, 1024, 1024, 2048, 1 << 30, 0l};
            S.init(g.M, g.N, gridDim.x, blockIdx.x);
            pg8::gemm_phase(lds, g, S, pg8::EpiCT{(bf16_t*)(p.ws + OFF_CT)});
        }
        {
            pg8::Gemm g{slotB, (const bf16_t*)(p.ws + OFF_WIN) + (size_t)2048 * 1024, T_ALL, 1536, 1024, 2048, 1024, 1 << 30, 0l};
            S.init(g.M, g.N, gridDim.x, (blockIdx.x + gridDim.x / 2) % gridDim.x);
            pg8::gemm_phase(lds, g, S, pg8::EpiQKG{(bf16_t*)(p.ws + OFF_Q), (bf16_t*)(p.ws + OFF_K), (bf16_t*)(p.ws + OFF_SG), (const v2f*)(p.ws + OFF_ROT)});
        }
    }; phf(); if ((DUP_MASK >> 4) & 1) phf(); }
    if (ph_lo < 5 && ph_hi > 5) PHASE_SYNC();
    if (RUN(5)) { auto phf = [&]() { for (int u = blockIdx.x; u < 1536 * REP5; u += gridDim.x) ret_state_unit(p, u % 1536, lds); }; phf(); if ((DUP_MASK >> 5) & 1) phf(); }
    if (ph_lo < 6 && ph_hi > 6) PHASE_SYNC();
    int rep6 = 0;
    if (RUN(6)) { auto phf = [&]() {
        if (rep6++ == 0) ret_scan(p);
        LAS v2f* buf = (LAS v2f*)lds; LAS float* red = (LAS float*)(lds + FFT_BYTES); LAS unsigned short* stg = (LAS unsigned short*)(lds + FFT_BYTES + 1024);
        unsigned* zscr = (unsigned*)(p.ws + WS_END) + (size_t)blockIdx.x * 16384;
        unsigned* kscr = (unsigned*)(p.ws + OFF_WUP1) + (size_t)blockIdx.x * 16384;
        for (int u = blockIdx.x; u < 512 * HY_REP; u += gridDim.x) hyena_channel<CfgBig>(p, buf, red, stg, kscr, zscr, tid, 1, u & 511, u >= 512 * (HY_REP - 1));
        for (int u = blockIdx.x; u < 256 * HY_REP; u += gridDim.x) { const int hb = tid >> 8; hyena_channel<CfgSmall>(p, buf + hb * CfgSmall::PHYS, red + hb * 32, stg + hb * 4096, kscr + hb * 8192, zscr + hb * 8192, tid & 255, 0, (u & 255) * 2 + hb, u >= 256 * (HY_REP - 1)); }
    }; phf(); if ((DUP_MASK >> 6) & 1) phf(); }
    if (ph_lo < 7 && ph_hi > 7) PHASE_SYNC();
    if (RUN(7)) { auto phf = [&]() { for (int u = blockIdx.x; u < 1536 * REP7; u += gridDim.x) ret_out_unit(p, u % 1536, lds, u >= 1536 * (REP7 - 1));
        for (int u = blockIdx.x; u < 1536; u += gridDim.x) yh_transpose_tile(p, u, (LAS bf16_t*)lds); }; phf(); if ((DUP_MASK >> 7) & 1) phf(); }
    if (ph_lo < 8 && ph_hi > 8) PHASE_SYNC();
    if (RUN(8)) { auto phf = [&]() {
        pg8::Gemm g{(const bf16_t*)(p.ws + OFF_KT), (const bf16_t*)(p.ws + OFF_WOUT), T_ALL, 1024, 1024, 512, 1024, 8, (long)OFF_Q - (long)OFF_KT - 8 * 128};
        S.init(g.M, g.N, gridDim.x, blockIdx.x);
        pg8::gemm_phase(lds, g, S, pg8::EpiBf16{slotB, 2048});
    }; phf(); if ((DUP_MASK >> 8) & 1) phf(); }
    if (ph_lo < 9 && ph_hi > 9) PHASE_SYNC();
    if (RUN(9)) { auto phf = [&]() { row_phase(p, 2, p.in[23], p.in[24]); }; phf(); if ((DUP_MASK >> 9) & 1) phf(); }
    if (ph_lo < 10 && ph_hi > 10) PHASE_SYNC();
    if (RUN(10)) { auto phf = [&]() {
        pg8::Gemm g{slotB, (const bf16_t*)(p.ws + OFF_WUP2), T_ALL, 5632, 1024, 2048, 1024, 1 << 30, 0l};
        S.init(g.M, g.N, gridDim.x, blockIdx.x);
        pg8::gemm_phase(lds, g, S, pg8::EpiSwiglu{(bf16_t*)(p.ws + OFF_G), 2816});
    }; phf(); if ((DUP_MASK >> 10) & 1) phf(); }
    if (ph_lo < 11 && ph_hi > 11) PHASE_SYNC();
    if (RUN(11)) { auto phf = [&]() {
        pg8::Gemm g{(const bf16_t*)(p.ws + OFF_G), (const bf16_t*)(p.ws + OFF_WDN2), T_ALL, 1024, 2816, 2816, 2816, 1 << 30, 0l};
        S.init(g.M, g.N, gridDim.x, blockIdx.x);
        pg8::gemm_phase(lds, g, S, pg8::EpiBf16{slotB, 2048});
    }; phf(); if ((DUP_MASK >> 11) & 1) phf(); }
    if (ph_lo < 12 && ph_hi > 12) PHASE_SYNC();
    if (RUN(12)) { auto phf = [&]() { row_phase(p, 3, p.in[28], nullptr); }; phf(); if ((DUP_MASK >> 12) & 1) phf(); }
}

#ifndef MULTI_LAUNCH
#define MULTI_LAUNCH 0
#endif
extern "C" void kernel_launch(void* const* d_in, const int* in_sizes, int n_in, void* d_out, int out_size, void* d_ws, size_t ws_size, hipStream_t stream) {
    static int grid_blocks = 0;
    if (!grid_blocks) {
        hipFuncSetAttribute((const void*)hybrid_forward, hipFuncAttributeMaxDynamicSharedMemorySize, SMEM_BYTES + 16);
        int dev = 0, cus = 0, per_cu = 0;
        hipGetDevice(&dev);
        hipDeviceGetAttribute(&cus, hipDeviceAttributeMultiprocessorCount, dev);
        hipOccupancyMaxActiveBlocksPerMultiprocessor(&per_cu, hybrid_forward, 512, SMEM_BYTES + 16);
        grid_blocks = cus * per_cu;
        if (grid_blocks <= 0 || grid_blocks > 256) grid_blocks = 256;
    }
    Params p{};
    for (int i = 0; i < 29; ++i) p.in[i] = (const float*)d_in[i];
    p.out = (float*)d_out; p.ws = (char*)d_ws;
#if MULTI_LAUNCH
    for (int ph = 0; ph < 13; ++ph) { p.ph_lo = ph; p.ph_hi = ph + 1; hipLaunchKernelGGL(hybrid_forward, dim3(256), dim3(512), 0, stream, p); }
#else
    p.ph_lo = 0; p.ph_hi = 13;
    hipMemsetAsync((char*)d_ws + OFF_BAR, 0, XCD_BAR_WORDS * 4, stream);
    void* args[] = {&p};
    hipError_t e = hipLaunchCooperativeKernel((void*)hybrid_forward, dim3(grid_blocks), dim3(512), args, SMEM_BYTES + 16, stream);
    if (e != hipSuccess) fprintf(stderr, "cooperative launch failed: %s\n", hipGetErrorString(e));
#endif
}
```

```cpp
#include <hip/hip_runtime.h>
#include <hip/hip_fp16.h>
#include <hip/hip_cooperative_groups.h>
#include <cstdio>
namespace cg = cooperative_groups;

#define LAS __attribute__((address_space(3)))
typedef unsigned short bf16_t;
typedef short bf16x8 __attribute__((ext_vector_type(8)));
typedef float f32x4 __attribute__((ext_vector_type(4)));
typedef float v2f __attribute__((ext_vector_type(2)));
typedef unsigned u32x4 __attribute__((ext_vector_type(4)));
typedef unsigned u32x2 __attribute__((ext_vector_type(2)));

#ifndef EXTRA_SYNCS
#define EXTRA_SYNCS 0
#endif
#ifndef REP7
#define REP7 1
#endif
#ifndef REP5
#define REP5 1
#endif
#ifndef REP_TR
#define REP_TR 1
#endif
#ifndef REP_FILT
#define REP_FILT 1
#endif
#ifndef REP_ROW0
#define REP_ROW0 1
#endif
constexpr int T_ALL = 49152, T_P = 16384;
constexpr size_t U_BYTES = (size_t)T_ALL * 1024 * 2;
constexpr size_t SZ_WUP = (size_t)5632 * 1024 * 2, SZ_WDN = (size_t)1024 * 2816 * 2, SZ_WIN = (size_t)4096 * 1024 * 2, SZ_WOUT = (size_t)1024 * 1024 * 2;
constexpr size_t SZ_ROT = (size_t)8192 * 64 * 8, SZ_HRAW = (size_t)2048 * 12288 * 2;
constexpr size_t OFF_WUP1 = 0, OFF_WDN1 = OFF_WUP1 + SZ_WUP, OFF_WIN = OFF_WDN1 + SZ_WDN, OFF_WOUT = OFF_WIN + SZ_WIN, OFF_WUP2 = OFF_WOUT + SZ_WOUT,
                 OFF_WDN2 = OFF_WUP2 + SZ_WUP, OFF_ROT = OFF_WDN2 + SZ_WDN, OFF_ROTT = OFF_ROT + SZ_ROT, OFF_HRAW = OFF_ROTT + SZ_ROT, OFF_BIG = OFF_HRAW + SZ_HRAW;
constexpr size_t OFF_G = OFF_BIG;
constexpr size_t OFF_CT = OFF_BIG;
constexpr size_t OFF_Q = OFF_CT + 2 * U_BYTES;
constexpr size_t OFF_K = OFF_Q + U_BYTES / 2;
constexpr size_t OFF_SG = OFF_K + U_BYTES / 2;
constexpr size_t OFF_KT = OFF_SG + U_BYTES / 2;
constexpr size_t WS_END = OFF_KT + U_BYTES / 2;
static_assert(WS_END + (size_t)256 * 65536 + 16384 <= (size_t)536870912, "workspace");
constexpr size_t OFF_BAR = WS_END + (size_t)256 * 65536;
constexpr int FFT_BYTES = 143360;
constexpr int SMEM_BYTES = FFT_BYTES + 1024 + 16384;

struct Params {
    const float* in[29];
    float* out;
    char* ws;
    int ph_lo, ph_hi;
};

__device__ __forceinline__ unsigned short f2bf(float f) { unsigned u = __float_as_uint(f); u += 0x7fffu + ((u >> 16) & 1u); return (unsigned short)(u >> 16); }
__device__ __forceinline__ float bf2f(unsigned short h) { return __uint_as_float(((unsigned)h) << 16); }
__device__ __forceinline__ unsigned pack_bf(float lo, float hi) { unsigned r; asm("v_cvt_pk_bf16_f32 %0, %1, %2" : "=v"(r) : "v"(lo), "v"(hi)); return r; }
__device__ __forceinline__ float bflo(unsigned w) { return __uint_as_float(w << 16); }
__device__ __forceinline__ float bfhi(unsigned w) { return __uint_as_float(w & 0xffff0000u); }
__device__ __forceinline__ int row_base(int bb) { return bb < 4 ? bb * 4096 : 16384 + (bb - 4) * 8192; }
__device__ __forceinline__ void row_info(int r, int& rb, int& L) { if (r < T_P) { L = 4096; rb = r & ~4095; } else { L = 8192; rb = T_P + ((r - T_P) & ~8191); } }
__device__ __forceinline__ float wave_sum(float v) {
#pragma unroll
    for (int o = 32; o; o >>= 1) v += __shfl_xor(v, o);
    return v;
}
__device__ __forceinline__ float silu_f(float x) { return x * __builtin_amdgcn_rcpf(1.0f + __builtin_amdgcn_exp2f(x * -1.4426950408889634f)); }
namespace pg8 {
constexpr int BM = 256, BK = 64, HALF = 128, HTB = HALF * BK * 2, STAGE_BYTES = 8 * HTB, NXCD = 8, WGM = 8;
__device__ __forceinline__ int lds_byte(int r, int c) { const int st = (r >> 4) * 2 + (c >> 5), rr = r & 15, cc = c & 31, ob = rr * 64 + cc * 2; return st * 1024 + (ob ^ (((ob >> 9) & 1) << 5)); }
__device__ __forceinline__ void stage_rc(int b, int& R, int& C) { const int st = b / 1024, sb = b % 1024, swz = sb ^ (((sb >> 9) & 1) << 5); R = (st >> 1) * 16 + swz / 64; C = (st & 1) * 32 + (swz % 64) / 2; }
__device__ __forceinline__ int perm32(int rho) { const int n = rho >> 4, i = rho & 15; return 8 * (i >> 2) + 4 * n + (i & 3); }
struct Unit { int pm, pn; };
struct Gemm { const bf16_t* A; const bf16_t* Bt; int M, N, K, lda, ldb, ksplit; long asplit; };
struct StaticOrder {
    int nM, nN, nwg, G, c;
    __device__ void init(int M, int N, int G_, int c_) { nM = M / BM; nN = N / BM; nwg = nM * nN; G = G_; c = c_; }
    __device__ bool next(int i, Unit& u) const {
        const long L = (long)i * G + c; if (L >= nwg) return false;
        int wgid = (int)L; { const int q = nwg / NXCD, r = nwg % NXCD, xcd = wgid % NXCD, off = wgid / NXCD; wgid = (xcd < r ? xcd * (q + 1) : r * (q + 1) + (xcd - r) * q) + off; }
        const int nig = WGM * nN, gid = wgid / nig, fm = gid * WGM, gsz = (nM - fm) < WGM ? (nM - fm) : WGM;
        u.pm = fm + ((wgid % nig) % gsz); u.pn = (wgid % nig) / gsz; return true;
    }
};
__device__ __forceinline__ unsigned cvt_pk_bf16(float lo, float hi) { unsigned r; asm volatile("v_cvt_pk_bf16_f32 %0, %1, %2" : "=v"(r) : "v"(lo), "v"(hi)); return r; }

template <class Epi, class Sched>
__device__ __forceinline__ void gemm_phase(LAS unsigned char* lds, const Gemm g, const Sched& S, const Epi& E) {
    const int tid = threadIdx.x, wid = __builtin_amdgcn_readfirstlane(tid >> 6), lane = tid & 63, wr = wid >> 2, wc = wid & 3, fr = lane & 15, fq = lane >> 4;
    const int K = g.K, nt = K / BK;
    unsigned voffA[2], voffB[2];
#pragma unroll
    for (int i = 0; i < 2; ++i) { int R, C; stage_rc(tid * 16 + i * 8192, R, C); const int Rb = (R & ~31) + perm32(R & 31);
        voffA[i] = (unsigned)(R * g.lda + C) * 2u; voffB[i] = (unsigned)(Rb * g.ldb + C) * 2u; }
    const size_t kstep = (size_t)(BK * 2);
    const size_t hstepA = (size_t)HALF * g.lda * 2, hstepB = (size_t)HALF * g.ldb * 2;
    const size_t tstepA = 2 * hstepA, tstepB = 2 * hstepB;
    const unsigned ldsw = (unsigned)wid * 1024u;
    const int aoff = lds_byte(wr * 64 + fr, fq * 8), boff = lds_byte(wc * 32 + fr, fq * 8);
    const int ksplit = g.ksplit; const long asplit = g.asplit;
#define PG8_AP(base, t) ((base) + (size_t)(t) * kstep + (((t) >= ksplit) ? asplit : 0l))
#define PG8_SA(b, h) (((b) * 2 + (h)) * HTB)
#define PG8_SB(b, h) ((4 + (b) * 2 + (h)) * HTB)
#define PG8_STAGE(bufoff, gbase, voff) do { _Pragma("unroll") for (int _i = 0; _i < 2; ++_i) \
        __builtin_amdgcn_global_load_lds((const unsigned*)((const char*)(gbase) + (voff)[_i]), (LAS unsigned*)(lds + (bufoff) + ldsw + _i * 8192), 16, 0, 0); } while (0)
#define PG8_LDA(dst, b, h) do { _Pragma("unroll") for (int m = 0; m < 4; ++m) _Pragma("unroll") for (int k = 0; k < 2; ++k) dst[m][k] = *(const LAS bf16x8*)(lds + PG8_SA(b, h) + aoff + m * 2048 + k * 1024); } while (0)
#define PG8_LDB(dst, b, h) do { _Pragma("unroll") for (int n = 0; n < 2; ++n) _Pragma("unroll") for (int k = 0; k < 2; ++k) dst[n][k] = *(const LAS bf16x8*)(lds + PG8_SB(b, h) + boff + n * 2048 + k * 1024); } while (0)
#define PG8_MMA(ai, bj, At, Bt) do { __builtin_amdgcn_s_setprio(1); _Pragma("unroll") for (int m = 0; m < 4; ++m) _Pragma("unroll") for (int n = 0; n < 2; ++n) _Pragma("unroll") for (int k = 0; k < 2; ++k) \
        acc[ai][bj][m][n] = __builtin_amdgcn_mfma_f32_16x16x32_bf16(Bt[n][k], At[m][k], acc[ai][bj][m][n], 0, 0, 0); __builtin_amdgcn_s_setprio(0); } while (0)
#define PG8_WAIT_V(n) asm volatile("s_waitcnt vmcnt(" #n ")" ::: "memory")
#define PG8_WAIT_L(n) asm volatile("s_waitcnt lgkmcnt(" #n ")" ::: "memory")
#define PG8_BAR __builtin_amdgcn_s_barrier()
#define PG8_SCHED __builtin_amdgcn_sched_barrier(0)
    Unit cur, nxt; int ui = 0;
    if (!S.next(0, cur)) return;
    f32x4 acc[2][2][4][2];
#pragma unroll
    for (int a = 0; a < 2; ++a)
#pragma unroll
        for (int b = 0; b < 2; ++b)
#pragma unroll
            for (int m = 0; m < 4; ++m)
#pragma unroll
                for (int n = 0; n < 2; ++n) acc[a][b][m][n] = (f32x4){0.f, 0.f, 0.f, 0.f};
    bf16x8 At[4][2], B0[2][2], B1[2][2];
    const char* cA = (const char*)g.A + (size_t)cur.pm * tstepA; const char* cB = (const char*)g.Bt + (size_t)cur.pn * tstepB;
    PG8_STAGE(PG8_SB(0, 0), cB, voffB); PG8_STAGE(PG8_SA(0, 0), cA, voffA); PG8_STAGE(PG8_SB(0, 1), cB + hstepB, voffB); PG8_STAGE(PG8_SA(0, 1), cA + hstepA, voffA);
    if (wr == 1) PG8_BAR;
    PG8_WAIT_V(4); PG8_BAR;
    PG8_STAGE(PG8_SB(1, 0), cB + kstep, voffB); PG8_STAGE(PG8_SA(1, 0), cA + kstep, voffA); PG8_STAGE(PG8_SB(1, 1), cB + hstepB + kstep, voffB);
    PG8_WAIT_V(6); PG8_BAR;
    for (;;) {
        const bool has_next = S.next(ui + 1, nxt);
        const char* nA = has_next ? (const char*)g.A + (size_t)nxt.pm * tstepA : cA; const char* nB = has_next ? (const char*)g.Bt + (size_t)nxt.pn * tstepB : cB;
        for (int t = 0; t < nt; t += 2) {
            const bool last = (t == nt - 2);
            const char* a1 = PG8_AP(cA, t + 1);
            const char* a2 = last ? nA : PG8_AP(cA, t + 2); const char* b2 = last ? nB : cB + (size_t)(t + 2) * kstep;
            const char* a3 = last ? nA + kstep : PG8_AP(cA, t + 3); const char* b3 = b2 + kstep;
            PG8_LDB(B0, 0, 0); PG8_SCHED; PG8_LDA(At, 0, 0); PG8_STAGE(PG8_SA(1, 1), a1 + hstepA, voffA);
            PG8_WAIT_L(8); PG8_BAR; PG8_WAIT_L(0); PG8_MMA(0, 0, At, B0); PG8_BAR; PG8_SCHED;
            PG8_LDB(B1, 0, 1); PG8_STAGE(PG8_SB(0, 0), b2, voffB);
            PG8_BAR; PG8_WAIT_L(0); PG8_MMA(0, 1, At, B1); PG8_BAR;
            PG8_LDA(At, 0, 1); PG8_STAGE(PG8_SA(0, 0), a2, voffA);
            PG8_BAR; PG8_WAIT_L(0); PG8_MMA(1, 0, At, B0); PG8_BAR; PG8_SCHED;
            PG8_STAGE(PG8_SB(0, 1), b2 + hstepB, voffB);
            PG8_WAIT_V(6); PG8_BAR; PG8_MMA(1, 1, At, B1); PG8_BAR;
            PG8_LDB(B0, 1, 0); PG8_SCHED; PG8_LDA(At, 1, 0); PG8_STAGE(PG8_SA(0, 1), a2 + hstepA, voffA);
            PG8_WAIT_L(8); PG8_BAR; PG8_WAIT_L(0); PG8_MMA(0, 0, At, B0); PG8_BAR; PG8_SCHED;
            PG8_LDB(B1, 1, 1); PG8_STAGE(PG8_SB(1, 0), b3, voffB);
            PG8_BAR; PG8_WAIT_L(0); PG8_MMA(0, 1, At, B1); PG8_BAR;
            PG8_LDA(At, 1, 1); PG8_STAGE(PG8_SA(1, 0), a3, voffA);
            PG8_BAR; PG8_WAIT_L(0); PG8_MMA(1, 0, At, B0); PG8_BAR; PG8_SCHED;
            PG8_STAGE(PG8_SB(1, 1), b3 + hstepB, voffB);
            PG8_WAIT_V(6); PG8_BAR; PG8_MMA(1, 1, At, B1); PG8_BAR;
        }
        { int l2 = threadIdx.x & 63; asm volatile("" : "+v"(l2)); E(acc, cur, wr, wc, l2 & 15, l2 >> 4); }
        if (!has_next) break;
#pragma unroll
        for (int a = 0; a < 2; ++a)
#pragma unroll
            for (int b = 0; b < 2; ++b)
#pragma unroll
                for (int m = 0; m < 4; ++m)
#pragma unroll
                    for (int n = 0; n < 2; ++n) acc[a][b][m][n] = (f32x4){0.f, 0.f, 0.f, 0.f};
        cur = nxt; cA = nA; cB = nB; ++ui;
    }
    PG8_WAIT_V(0);
    if (wr == 0) PG8_BAR;
    PG8_BAR;
#undef PG8_AP
#undef PG8_SA
#undef PG8_SB
#undef PG8_STAGE
#undef PG8_LDA
#undef PG8_LDB
#undef PG8_MMA
#undef PG8_WAIT_V
#undef PG8_WAIT_L
#undef PG8_BAR
#undef PG8_SCHED
}

struct EpiBf16 {
    bf16_t* O; int ldc;
    __device__ __forceinline__ void operator()(const f32x4 (&acc)[2][2][4][2], const Unit& u, int wr, int wc, int fr, int fq) const {
        const int row0 = u.pm * BM + wr * 64 + fr, col0 = u.pn * BM + wc * 32 + 8 * fq;
#pragma unroll
        for (int ai = 0; ai < 2; ++ai)
#pragma unroll
            for (int m = 0; m < 4; ++m) { bf16_t* rowp = O + (size_t)(row0 + ai * HALF + m * 16) * ldc + col0;
#pragma unroll
                for (int bj = 0; bj < 2; ++bj) { const f32x4 v0 = acc[ai][bj][m][0], v1 = acc[ai][bj][m][1];
                    u32x4 w; w.x = cvt_pk_bf16(v0[0], v0[1]); w.y = cvt_pk_bf16(v0[2], v0[3]); w.z = cvt_pk_bf16(v1[0], v1[1]); w.w = cvt_pk_bf16(v1[2], v1[3]);
                    *(u32x4*)(rowp + bj * HALF) = w; } }
    }
};
struct EpiSwiglu {
    bf16_t* O; int ldc;
    __device__ __forceinline__ void operator()(const f32x4 (&acc)[2][2][4][2], const Unit& u, int wr, int wc, int fr, int fq) const {
        const int row0 = u.pm * BM + wr * 64 + fr, col0 = u.pn * HALF + wc * 32 + 8 * fq;
#pragma unroll
        for (int ai = 0; ai < 2; ++ai)
#pragma unroll
            for (int m = 0; m < 4; ++m) { bf16_t* rowp = O + (size_t)(row0 + ai * HALF + m * 16) * ldc + col0;
                float r[8];
#pragma unroll
                for (int n = 0; n < 2; ++n)
#pragma unroll
                    for (int j = 0; j < 4; ++j) { const float gt = acc[ai][0][m][n][j], up = acc[ai][1][m][n][j]; r[n * 4 + j] = silu_f(gt) * up; }
                u32x4 w; w.x = cvt_pk_bf16(r[0], r[1]); w.y = cvt_pk_bf16(r[2], r[3]); w.z = cvt_pk_bf16(r[4], r[5]); w.w = cvt_pk_bf16(r[6], r[7]);
                *(u32x4*)rowp = w; }
    }
};
struct EpiCT {
    bf16_t* CT;
    __device__ __forceinline__ void operator()(const f32x4 (&acc)[2][2][4][2], const Unit& u, int wr, int wc, int fr, int fq) const {
        const int r0 = u.pn * BM; int rb, L; row_info(r0, rb, L);
        const int tloc = (r0 - rb) + wc * 32 + 8 * fq;
        {
            bf16_t* base = CT + (size_t)rb * 2048 + tloc;
#pragma unroll
            for (int ai = 0; ai < 2; ++ai)
#pragma unroll
                for (int m = 0; m < 4; ++m) { const int ch = u.pm * BM + ai * HALF + wr * 64 + m * 16 + fr; bf16_t* rowp = base + (size_t)ch * L;
#pragma unroll
                    for (int bj = 0; bj < 2; ++bj) { const f32x4 v0 = acc[ai][bj][m][0], v1 = acc[ai][bj][m][1];
                        u32x4 w; w.x = cvt_pk_bf16(v0[0], v0[1]); w.y = cvt_pk_bf16(v0[2], v0[3]); w.z = cvt_pk_bf16(v1[0], v1[1]); w.w = cvt_pk_bf16(v1[2], v1[3]);
                        *(u32x4*)(rowp + bj * HALF) = w; } }
        }
    }
};
struct EpiQKG {
    bf16_t* Q; bf16_t* Kk; bf16_t* SG; const v2f* rot;
    __device__ __forceinline__ void operator()(const f32x4 (&acc)[2][2][4][2], const Unit& u, int wr, int wc, int fr, int fq) const {
        const int row0 = u.pm * BM + wr * 64 + fr; int rb, L; row_info(u.pm * BM, rb, L);
        if (u.pn < 4) {
            bf16_t* O = (u.pn < 2) ? Q : Kk; const float sc = (u.pn < 2) ? 1.0f : 0.08838834764831845f;
            const int head = 2 * (u.pn & 1) + (wc >> 1), dd0 = (wc & 1) * 32 + 8 * fq;
            f32x4 cb[4], s16[4], s128[4];
            { const v2f* rp = rot + (size_t)(row0 - rb) * 64 + dd0; const v2f* r16 = rot + (size_t)16 * 64 + dd0; const v2f* r128 = rot + (size_t)128 * 64 + dd0;
#pragma unroll
              for (int i = 0; i < 4; ++i) { cb[i] = *(const f32x4*)(rp + 2 * i); s16[i] = *(const f32x4*)(r16 + 2 * i); s128[i] = *(const f32x4*)(r128 + 2 * i); } }
#pragma unroll
            for (int ai = 0; ai < 2; ++ai) {
                f32x4 cur[4];
#pragma unroll
                for (int i = 0; i < 4; ++i) { cur[i] = cb[i];
                    if (ai == 1) { f32x4 t; t[0] = cb[i][0] * s128[i][0] - cb[i][1] * s128[i][1]; t[1] = cb[i][0] * s128[i][1] + cb[i][1] * s128[i][0];
                        t[2] = cb[i][2] * s128[i][2] - cb[i][3] * s128[i][3]; t[3] = cb[i][2] * s128[i][3] + cb[i][3] * s128[i][2]; cur[i] = t; } }
#pragma unroll
                for (int m = 0; m < 4; ++m) { const int row = row0 + ai * HALF + m * 16;
                    if (m > 0) {
#pragma unroll
                        for (int i = 0; i < 4; ++i) { f32x4 t; t[0] = cur[i][0] * s16[i][0] - cur[i][1] * s16[i][1]; t[1] = cur[i][0] * s16[i][1] + cur[i][1] * s16[i][0];
                            t[2] = cur[i][2] * s16[i][2] - cur[i][3] * s16[i][3]; t[3] = cur[i][2] * s16[i][3] + cur[i][3] * s16[i][2]; cur[i] = t; } }
                    float o1[8], o2[8];
#pragma unroll
                    for (int n = 0; n < 2; ++n)
#pragma unroll
                        for (int j = 0; j < 4; ++j) { const int k = n * 4 + j; const float c = cur[k >> 1][(k & 1) * 2], sn = cur[k >> 1][(k & 1) * 2 + 1];
                            const float x1 = acc[ai][0][m][n][j], x2 = acc[ai][1][m][n][j];
                            o1[k] = (x1 * c - x2 * sn) * sc; o2[k] = (x1 * sn + x2 * c) * sc; }
                    bf16_t* dst = O + (size_t)row * 512 + head * 128 + dd0;
                    u32x4 w; w.x = cvt_pk_bf16(o1[0], o1[1]); w.y = cvt_pk_bf16(o1[2], o1[3]); w.z = cvt_pk_bf16(o1[4], o1[5]); w.w = cvt_pk_bf16(o1[6], o1[7]);
                    *(u32x4*)dst = w;
                    w.x = cvt_pk_bf16(o2[0], o2[1]); w.y = cvt_pk_bf16(o2[2], o2[3]); w.z = cvt_pk_bf16(o2[4], o2[5]); w.w = cvt_pk_bf16(o2[6], o2[7]);
                    *(u32x4*)(dst + 64) = w; } }
        } else {
            const int col0 = (u.pn - 4) * BM + wc * 32 + 8 * fq;
#pragma unroll
            for (int ai = 0; ai < 2; ++ai)
#pragma unroll
                for (int m = 0; m < 4; ++m) { bf16_t* rowp = SG + (size_t)(row0 + ai * HALF + m * 16) * 512 + col0;
#pragma unroll
                    for (int bj = 0; bj < 2; ++bj) { const f32x4 v0 = acc[ai][bj][m][0], v1 = acc[ai][bj][m][1];
                        u32x4 w; w.x = cvt_pk_bf16(silu_f(v0[0]), silu_f(v0[1])); w.y = cvt_pk_bf16(silu_f(v0[2]), silu_f(v0[3]));
                        w.z = cvt_pk_bf16(silu_f(v1[0]), silu_f(v1[1])); w.w = cvt_pk_bf16(silu_f(v1[2]), silu_f(v1[3]));
                        *(u32x4*)(rowp + bj * HALF) = w; } }
        }
    }
};
}
#define FFT_HD __device__ __forceinline__

FFT_HD v2f cmul(v2f a, v2f b) {
    v2f t, r;
    asm("v_pk_mul_f32 %0, %1, %2 op_sel_hi:[0,1]" : "=v"(t) : "v"(a), "v"(b));
    asm("v_pk_fma_f32 %0, %1, %2, %3 op_sel:[1,1,0] op_sel_hi:[1,0,1] neg_lo:[1,0,0]" : "=v"(r) : "v"(a), "v"(b), "v"(t));
    return r;
}
FFT_HD constexpr int brev_c(int x, int bits) { int r = 0; for (int i = 0; i < bits; ++i) r |= ((x >> i) & 1) << (bits - 1 - i); return r; }
template <int R> struct Log2R { static constexpr int v = (R == 32) ? 5 : (R == 16) ? 4 : (R == 8) ? 3 : (R == 4) ? 2 : 1; };
FFT_HD constexpr float cos32c(int i) {
    switch (i & 15) {
        case 0: return 1.0f; case 1: return 0.98078528040323043f; case 2: return 0.92387953251128674f; case 3: return 0.83146961230254524f;
        case 4: return 0.70710678118654752f; case 5: return 0.55557023301960218f; case 6: return 0.38268343236508977f; case 7: return 0.19509032201612825f;
        case 8: return 0.0f; case 9: return -0.19509032201612825f; case 10: return -0.38268343236508977f; case 11: return -0.55557023301960218f;
        case 12: return -0.70710678118654752f; case 13: return -0.83146961230254524f; case 14: return -0.92387953251128674f; default: return -0.98078528040323043f;
    }
}
FFT_HD constexpr float sin32c(int i) {
    switch (i & 15) {
        case 0: return 0.0f; case 1: return 0.19509032201612825f; case 2: return 0.38268343236508977f; case 3: return 0.55557023301960218f;
        case 4: return 0.70710678118654752f; case 5: return 0.83146961230254524f; case 6: return 0.92387953251128674f; case 7: return 0.98078528040323043f;
        case 8: return 1.0f; case 9: return 0.98078528040323043f; case 10: return 0.92387953251128674f; case 11: return 0.83146961230254524f;
        case 12: return 0.70710678118654752f; case 13: return 0.55557023301960218f; case 14: return 0.38268343236508977f; default: return 0.19509032201612825f;
    }
}
template <int R, bool INV> FFT_HD void dftR(v2f (&v)[R]) {
#pragma unroll
    for (int half = R / 2; half >= 1; half >>= 1) {
#pragma unroll
        for (int i = 0; i < R; ++i) {
            if ((i & half) == 0) {
                const int j = i + half;
                const int p = (i & (half - 1)) * (16 / half);
                const v2f a = v[i], b = v[j];
                v[i] = a + b;
                const v2f d = a - b;
                if (p == 0) { v[j] = d; }
                else {
                    const float c = cos32c(p), s = sin32c(p);
                    v2f r;
                    if (INV) { r.x = d.x * c - d.y * s; r.y = d.x * s + d.y * c; }
                    else     { r.x = d.x * c + d.y * s; r.y = d.y * c - d.x * s; }
                    v[j] = r;
                }
            }
        }
    }
}
template <int R> FFT_HD void tw_brev(v2f (&v)[R], v2f w) {
    v2f wk = w;
#pragma unroll
    for (int k = 1; k < R; ++k) { const int i = brev_c(k, Log2R<R>::v); v[i] = cmul(v[i], wk); wk = cmul(wk, w); }
}
template <int R> FFT_HD void tw_nat(v2f (&v)[R], v2f w) {
    v2f wk = w;
#pragma unroll
    for (int k = 1; k < R; ++k) { v[k] = cmul(v[k], wk); wk = cmul(wk, w); }
}
FFT_HD int opaque_i(int x) {
#if defined(__HIP_DEVICE_COMPILE__)
    asm volatile("" : "+v"(x));
#endif
    return x;
}
FFT_HD v2f unit_root(float frac2  , bool conj) {
    float s, c;
    sincospif(frac2, &s, &c);
    v2f w; w.x = c; w.y = conj ? s : -s; return w;
}

template <int N1_, int N2_, int N3_, int NT_> struct FftCfg {
    static constexpr int N1 = N1_, N2 = N2_, N3 = N3_, NT = NT_, N = N1_ * N2_ * N3_, S1 = N2_ * N3_;
    static constexpr int RS0 = S1 + S1 / 16;
    static constexpr int RS = RS0 + (((RS0 * 2) % 64 == 0) ? 16 : 0);
    static constexpr int PHYS = N1_ * RS;
    static constexpr int P2 = (N1_ * N3_) / NT_;
    static constexpr int P3 = (N1_ * N2_) / NT_;
};

template <class C, class BUF> FFT_HD void pass1_fwd(v2f (&v)[32], int lt, BUF buf) {
    static_assert(C::N1 == 32 && C::S1 == C::NT, "cfg");
    dftR<32, false>(v);
    tw_brev<32>(v, unit_root(2.0f * (float)opaque_i(lt) / (float)C::N, false));
#pragma unroll
    for (int k = 0; k < 32; ++k) buf[lt + (lt >> 4) + k * C::RS] = v[brev_c(k, 5)];
}
template <class C, bool INV, class BUF> FFT_HD void pass2(int lt, BUF buf) {
#pragma unroll 1
    for (int q = 0; q < C::P2; ++q) {
        const int d = lt + q * C::NT, k1 = d / C::N3, n3 = d % C::N3, base = k1 * C::RS + n3;
        v2f v[C::N2];
#pragma unroll
        for (int j = 0; j < C::N2; ++j) v[j] = buf[base + j * 17];
        const v2f w = unit_root(2.0f * (float)opaque_i(n3) / (float)(C::N2 * C::N3), INV);
        if (!INV) { dftR<C::N2, false>(v); tw_brev<C::N2>(v, w); }
        else      { tw_nat<C::N2>(v, w); dftR<C::N2, true>(v); }
#pragma unroll
        for (int k = 0; k < C::N2; ++k) buf[base + k * 17] = v[brev_c(k, Log2R<C::N2>::v)];
    }
}
template <class C, class BUF> FFT_HD void pass3_filter(int lt, BUF buf, unsigned* ks, float bias) {
    static_assert(C::N3 == 16, "cfg");
#pragma unroll
    for (int q = 0; q < C::P3; ++q) {
        const int dd = lt + q * C::NT, base = (dd / C::N2) * C::RS + (dd % C::N2) * 17;
        v2f v[16];
#pragma unroll
        for (int j = 0; j < 16; ++j) v[j] = buf[base + j];
        dftR<16, false>(v);
#pragma unroll
        for (int k = 0; k < 16; ++k) { const v2f x = v[brev_c(k, 4)]; const __half2 hh = __floats2half2_rn(x.x + bias, x.y);
            ks[(q * 16 + k) * C::NT + lt] = __builtin_bit_cast(unsigned, hh); }
    }
}
template <class C, class BUF> FFT_HD void pass3_fused(int lt, BUF buf, const unsigned* ks) {
#pragma unroll
    for (int q = 0; q < C::P3; ++q) {
        const int dd = lt + q * C::NT, base = (dd / C::N2) * C::RS + (dd % C::N2) * 17;
        v2f v[16], u[16];
        unsigned kw[16];
#pragma unroll
        for (int k = 0; k < 16; ++k) kw[k] = ks[(q * 16 + k) * C::NT + lt];
#pragma unroll
        for (int j = 0; j < 16; ++j) v[j] = buf[base + j];
        dftR<16, false>(v);
#pragma unroll
        for (int k = 0; k < 16; ++k) { const float2 kf = __half22float2(__builtin_bit_cast(__half2, kw[k])); v2f kk; kk.x = kf.x; kk.y = kf.y; u[k] = cmul(v[brev_c(k, 4)], kk); }
        dftR<16, true>(u);
#pragma unroll
        for (int n = 0; n < 16; ++n) buf[base + n] = u[brev_c(n, 4)];
    }
}
template <class C, class BUF> FFT_HD void pass1_inv(v2f (&v)[32], int lt, BUF buf) {
#pragma unroll
    for (int k = 0; k < 32; ++k) v[k] = buf[lt + (lt >> 4) + k * C::RS];
    tw_nat<32>(v, unit_root(2.0f * (float)opaque_i(lt) / (float)C::N, true));
    dftR<32, true>(v);
}

__device__ __forceinline__ int perm_qk(int x) { const int head = x >> 7, d = x & 127; return (head >> 1) * 256 + (d >> 6) * 128 + (head & 1) * 64 + (d & 63); }

__device__ void transpose_tile(const float* __restrict__ src, int srcN, int k0, int n0, bf16_t* dst, int dstld, int job, LAS float* tile) {
    const int tid = threadIdx.x;
#pragma unroll
    for (int i = 0; i < 8; ++i) { const int kk = (tid >> 6) + i * 8, nn = tid & 63; tile[kk * 65 + nn] = src[(size_t)(k0 + kk) * srcN + n0 + nn]; }
    __syncthreads();
    const int nn = tid >> 3, kk8 = (tid & 7) * 8, n = n0 + nn;
    u32x4 w;
    w.x = pack_bf(tile[(kk8 + 0) * 65 + nn], tile[(kk8 + 1) * 65 + nn]); w.y = pack_bf(tile[(kk8 + 2) * 65 + nn], tile[(kk8 + 3) * 65 + nn]);
    w.z = pack_bf(tile[(kk8 + 4) * 65 + nn], tile[(kk8 + 5) * 65 + nn]); w.w = pack_bf(tile[(kk8 + 6) * 65 + nn], tile[(kk8 + 7) * 65 + nn]);
    int row = n, row2 = -1;
    if (job == 0) row = (n >> 7) * 256 + (n & 127);
    else if (job == 1) row = (n >> 7) * 256 + 128 + (n & 127);
    else if (job == 3) {
        if (n < 1536) row = n;
        else if (n < 2048) row = 2048 + perm_qk(n - 1536);
        else if (n < 2560) row = 2560 + perm_qk(n - 2048);
        else if (n < 3072) row = 1536 + (n - 2560);
        else row = 3072 + (n - 3072);
    }
    *(u32x4*)(dst + (size_t)row * dstld + k0 + kk8) = w;
    if (row2 >= 0) *(u32x4*)(dst + (size_t)row2 * dstld + k0 + kk8) = w;
    __syncthreads();
}

__device__ void phase0_transposes(const Params& p, LAS float* tile) {
    for (int t = blockIdx.x; t < 5376 * REP_TR; t += gridDim.x) {
        int r = t % 5376;
        if (r < 704) { transpose_tile(p.in[3], 2816, (r / 44) * 64, (r % 44) * 64, (bf16_t*)(p.ws + OFF_WUP1), 1024, 0, tile); continue; } r -= 704;
        if (r < 704) { transpose_tile(p.in[4], 2816, (r / 44) * 64, (r % 44) * 64, (bf16_t*)(p.ws + OFF_WUP1), 1024, 1, tile); continue; } r -= 704;
        if (r < 704) { transpose_tile(p.in[5], 1024, (r / 16) * 64, (r % 16) * 64, (bf16_t*)(p.ws + OFF_WDN1), 2816, 2, tile); continue; } r -= 704;
        if (r < 896) { transpose_tile(p.in[8], 3584, (r / 56) * 64, (r % 56) * 64, (bf16_t*)(p.ws + OFF_WIN), 1024, 3, tile); continue; } r -= 896;
        if (r < 256) { transpose_tile(p.in[22], 1024, (r / 16) * 64, (r % 16) * 64, (bf16_t*)(p.ws + OFF_WOUT), 1024, 2, tile); continue; } r -= 256;
        if (r < 704) { transpose_tile(p.in[25], 2816, (r / 44) * 64, (r % 44) * 64, (bf16_t*)(p.ws + OFF_WUP2), 1024, 0, tile); continue; } r -= 704;
        if (r < 704) { transpose_tile(p.in[26], 2816, (r / 44) * 64, (r % 44) * 64, (bf16_t*)(p.ws + OFF_WUP2), 1024, 1, tile); continue; } r -= 704;
        transpose_tile(p.in[27], 1024, (r / 16) * 64, (r % 16) * 64, (bf16_t*)(p.ws + OFF_WDN2), 2816, 2, tile);
    }
}

__device__ void phase0_rot(const Params& p) {
    v2f* rot = (v2f*)(p.ws + OFF_ROT);
    for (int i = blockIdx.x * 512 + threadIdx.x; i < 8192 * 64; i += gridDim.x * 512) {
        const int pos = i >> 6, f = i & 63;
        const float inv = 1.0f / powf(10000.0f, (float)(2 * f) / 128.0f);
        const float ang = (float)pos * inv;
        float s, c; sincosf(ang, &s, &c);
        v2f cs; cs.x = c; cs.y = s;
        rot[i] = cs;
    }
}

__device__ __forceinline__ const float* x_row(const Params& p, int r) { return r < T_P ? p.in[0] + (size_t)r * 1024 : p.in[1] + (size_t)(r - T_P) * 1024; }
__device__ __forceinline__ void load_bf_row(const char* base, int lane, float (&v)[16]) {
#pragma unroll
    for (int i = 0; i < 4; ++i) { const u32x2 w = *(const u32x2*)(base + (lane * 4 + 256 * i) * 2); v[4 * i] = bflo(w.x); v[4 * i + 1] = bfhi(w.x); v[4 * i + 2] = bflo(w.y); v[4 * i + 3] = bfhi(w.y); }
}
__device__ __forceinline__ void store_bf_row(char* base, int lane, const float (&v)[16]) {
#pragma unroll
    for (int i = 0; i < 4; ++i) { u32x2 w; w.x = pack_bf(v[4 * i], v[4 * i + 1]); w.y = pack_bf(v[4 * i + 2], v[4 * i + 3]); *(u32x2*)(base + (lane * 4 + 256 * i) * 2) = w; }
}
__device__ __forceinline__ void load_f_row(const float* base, int lane, float (&v)[16]) {
#pragma unroll
    for (int i = 0; i < 4; ++i) { const f32x4 w = *(const f32x4*)(base + lane * 4 + 256 * i); v[4 * i] = w[0]; v[4 * i + 1] = w[1]; v[4 * i + 2] = w[2]; v[4 * i + 3] = w[3]; }
}
__device__ __forceinline__ float row_rs(const float (&v)[16]) { float ss = 0.f;
#pragma unroll
    for (int i = 0; i < 16; ++i) ss += v[i] * v[i];
    ss = wave_sum(ss); return rsqrtf(ss * (1.0f / 1024.0f) + 1e-6f); }

template <int mode>
__device__ __forceinline__ void row_finish(char* slot, int lane, float (&x)[16], float (&f)[16], float (&d)[16], const float (&g0)[16], const float (&g1)[16]) {
    if (mode == 0) {
        const float rs = row_rs(x); float h[16];
#pragma unroll
        for (int i = 0; i < 16; ++i) h[i] = x[i] * rs * g0[i];
        store_bf_row(slot + 2048, lane, h);
    } else {
        const float rs = row_rs(f);
        const float sc = (mode == 2) ? 1.0f : 0.5f;
        if (mode == 3) {
#pragma unroll
            for (int i = 0; i < 4; ++i) { f32x4 w;
#pragma unroll
                for (int j = 0; j < 4; ++j) w[j] = x[4 * i + j] + d[4 * i + j] + sc * f[4 * i + j] * rs * g0[4 * i + j];
                *(f32x4*)(slot + (lane * 4 + 256 * i) * 4) = w; }
        } else {
            float xn[16];
#pragma unroll
            for (int i = 0; i < 16; ++i) { float bb = sc * f[i] * rs * g0[i]; if (mode == 2) bb += d[i]; d[i] = bb; xn[i] = x[i] + bb; }
            store_bf_row(slot, lane, d);
            const float rs2 = row_rs(xn); float h[16];
#pragma unroll
            for (int i = 0; i < 16; ++i) h[i] = xn[i] * rs2 * g1[i];
            store_bf_row(slot + 2048, lane, h);
        }
    }
}
template <int mode>
__device__ void row_phase(const Params& p, const float* g0p, const float* g1p, int rep = 1) {
    const int lane = threadIdx.x & 63, gw = blockIdx.x * 8 + (threadIdx.x >> 6), nw = gridDim.x * 8;
    float g0[16], g1[16];
    load_f_row(g0p, lane, g0);
    if (g1p) load_f_row(g1p, lane, g1); else load_f_row(g0p, lane, g1);
    const int total = T_ALL * rep;
    for (int rr = gw; rr < total; rr += 2 * nw) {
        const bool two = rr + nw < total;
        const int r0 = rr % T_ALL, r1 = two ? (rr + nw) % T_ALL : r0;
        char* slot0 = (char*)p.out + (size_t)r0 * 4096; char* slot1 = (char*)p.out + (size_t)r1 * 4096;
        float x0[16], f0[16], d0[16], x1[16], f1[16], d1[16];
        load_f_row(x_row(p, r0), lane, x0); load_f_row(x_row(p, r1), lane, x1);
        if (mode >= 1) { load_bf_row(slot0 + 2048, lane, f0); load_bf_row(slot1 + 2048, lane, f1); }
        if (mode >= 2) { load_bf_row(slot0, lane, d0); load_bf_row(slot1, lane, d1); }
        row_finish<mode>(slot0, lane, x0, f0, d0, g0, g1);
        if (two) row_finish<mode>(slot1, lane, x1, f1, d1, g0, g1);
    }
}

__device__ void filter_unit(const Params& p, int unit, LAS unsigned char* lds) {
    const int Lsel = unit >= 64 ? 1 : 0, L = Lsel ? 8192 : 4096, t0 = (Lsel ? unit - 64 : unit) * 64;
    LAS float* zs = (LAS float*)lds;
    LAS float* hA = zs + 64 * 33;
    LAS float* hB = hA + 64 * 65;
    LAS float* Ws = hB + 64 * 65;
    LAS bf16_t* h3b = (LAS bf16_t*)(Ws + 64 * 64);
    LAS bf16_t* w4t = h3b + 64 * 72;
    const int tid = threadIdx.x;
    const float* W1 = p.in[11]; const float* B1 = p.in[12]; const float* W2 = p.in[13]; const float* B2 = p.in[14];
    const float* W3 = p.in[15]; const float* B3 = p.in[16]; const float* W4 = p.in[17]; const float* FR = p.in[18];
    __syncthreads();
    if (tid < 64) {
        const int t = t0 + tid;
        zs[tid * 33] = (float)t / (float)(L - 1);
        const float w = 6.283185307179586f * (float)t / (float)L;
#pragma unroll 1
        for (int b = 0; b < 16; ++b) { const float fb = 1e-4f + (float)b * ((15.0f - 1e-4f) / 15.0f); const float a = fb * w; float s, c; sincosf(a, &s, &c);
            zs[tid * 33 + 1 + b] = c; zs[tid * 33 + 17 + b] = -s; }
    }
    for (int i = tid; i < 33 * 64; i += 512) Ws[i] = W1[i];
    __syncthreads();
    const int t = tid & 63, kg = tid >> 6;
#pragma unroll 1
    for (int layer = 0; layer < 3; ++layer) {
        const LAS float* hin = layer == 0 ? zs : (layer == 1 ? hA : hB);
        LAS float* hout = layer == 1 ? hB : hA;
        const int istr = layer == 0 ? 33 : 65, nin = layer == 0 ? 33 : 64;
        const float* Bp = layer == 0 ? B1 : (layer == 1 ? B2 : B3);
        float a[8];
#pragma unroll
        for (int i = 0; i < 8; ++i) a[i] = Bp[kg * 8 + i];
#pragma unroll 4
        for (int j = 0; j < nin; ++j) { const float hv = hin[t * istr + j];
            const f32x4 w0 = *(const LAS f32x4*)(Ws + j * 64 + kg * 8), w1 = *(const LAS f32x4*)(Ws + j * 64 + kg * 8 + 4);
            a[0] += hv * w0[0]; a[1] += hv * w0[1]; a[2] += hv * w0[2]; a[3] += hv * w0[3]; a[4] += hv * w1[0]; a[5] += hv * w1[1]; a[6] += hv * w1[2]; a[7] += hv * w1[3]; }
        __syncthreads();
        const float* Wn = layer == 0 ? W2 : W3;
        if (layer < 2) for (int i = tid; i < 64 * 64; i += 512) Ws[i] = Wn[i];
#pragma unroll
        for (int i = 0; i < 8; ++i) { const float hv = sinf(FR[kg * 8 + i] * a[i]); if (layer < 2) hout[t * 65 + kg * 8 + i] = hv; else h3b[t * 72 + kg * 8 + i] = f2bf(hv); }
        __syncthreads();
    }
    const int wid = tid >> 6, lane = tid & 63, lr = lane & 15, lq = lane >> 4;
    bf16x8 afr[4][2];
#pragma unroll
    for (int mt = 0; mt < 4; ++mt)
#pragma unroll
        for (int ks = 0; ks < 2; ++ks) afr[mt][ks] = *(const LAS bf16x8*)(h3b + (16 * mt + lr) * 72 + 32 * ks + lq * 8);
    __half* hraw = (__half*)(p.ws + OFF_HRAW) + (Lsel ? (size_t)2048 * 4096 : (size_t)0);
#pragma unroll 1
    for (int quarter = 0; quarter < 4; ++quarter) {
#pragma unroll 4
        for (int i = 0; i < 64; ++i) { const int k = i, col = tid;
            w4t[col * 68 + k] = f2bf(W4[(size_t)k * 2048 + quarter * 512 + col]); }
        __syncthreads();
        f32x4 acc[4][4];
#pragma unroll
        for (int mt = 0; mt < 4; ++mt)
#pragma unroll
            for (int nt = 0; nt < 4; ++nt) acc[mt][nt] = (f32x4){0.f, 0.f, 0.f, 0.f};
#pragma unroll
        for (int nt = 0; nt < 4; ++nt)
#pragma unroll
            for (int ks = 0; ks < 2; ++ks) { const LAS bf16_t* bp = w4t + (64 * wid + 16 * nt + lr) * 68 + 32 * ks + lq * 8;
                const u32x2 b0 = *(const LAS u32x2*)bp, b1 = *(const LAS u32x2*)(bp + 4);
                u32x4 bw; bw.x = b0.x; bw.y = b0.y; bw.z = b1.x; bw.w = b1.y;
                const bf16x8 bfr = __builtin_bit_cast(bf16x8, bw);
#pragma unroll
                for (int mt = 0; mt < 4; ++mt) acc[mt][nt] = __builtin_amdgcn_mfma_f32_16x16x32_bf16(afr[mt][ks], bfr, acc[mt][nt], 0, 0, 0); }
#pragma unroll
        for (int nt = 0; nt < 4; ++nt) { const int col = quarter * 512 + 64 * wid + 16 * nt + lr, c = col & 511;
            const float ad = 3.0701134573253944f + (float)c * ((15.350567286626972f - 3.0701134573253944f) / 511.0f);
#pragma unroll
            for (int mt = 0; mt < 4; ++mt) { const int tt = t0 + 16 * mt + lq * 4;
                __half2 h01 = __floats2half2_rn(acc[mt][nt][0] * expf(-((float)(tt + 0) / (float)(L - 1)) * ad), acc[mt][nt][1] * expf(-((float)(tt + 1) / (float)(L - 1)) * ad));
                __half2 h23 = __floats2half2_rn(acc[mt][nt][2] * expf(-((float)(tt + 2) / (float)(L - 1)) * ad), acc[mt][nt][3] * expf(-((float)(tt + 3) / (float)(L - 1)) * ad));
                u32x2 w; w.x = __builtin_bit_cast(unsigned, h01); w.y = __builtin_bit_cast(unsigned, h23);
                *(u32x2*)(hraw + (size_t)col * L + tt) = w; } }
        __syncthreads();
    }
}
__device__ __forceinline__ float ldbf(const bf16_t* p) { return bf2f(*p); }
template <int NT, int L>
__device__ __forceinline__ void stage_conv_row(const bf16_t* row, int lt, float w0, float w1, float w2, float b, LAS unsigned short* stage) {
#pragma unroll
    for (int i = 0; i < L / 8 / NT; ++i) {
        const int tb = (lt + i * NT) * 8;
        const u32x4 w = *(const u32x4*)(row + tb);
        const unsigned short lo = row[tb > 0 ? tb - 1 : 0], hi = row[tb + 8 < L ? tb + 8 : L - 1];
        float u[10];
        u[0] = tb > 0 ? bf2f(lo) : 0.f; u[9] = tb + 8 < L ? bf2f(hi) : 0.f;
        u[1] = bflo(w.x); u[2] = bfhi(w.x); u[3] = bflo(w.y); u[4] = bfhi(w.y); u[5] = bflo(w.z); u[6] = bfhi(w.z); u[7] = bflo(w.w); u[8] = bfhi(w.w);
        float r[8];
#pragma unroll
        for (int k = 0; k < 8; ++k) r[k] = u[k] * w0 + u[k + 1] * w1 + u[k + 2] * w2 + b;
        u32x4 o;
        o.x = __builtin_bit_cast(unsigned, __floats2half2_rn(r[0], r[1])); o.y = __builtin_bit_cast(unsigned, __floats2half2_rn(r[2], r[3]));
        o.z = __builtin_bit_cast(unsigned, __floats2half2_rn(r[4], r[5])); o.w = __builtin_bit_cast(unsigned, __floats2half2_rn(r[6], r[7]));
        *(LAS u32x4*)(stage + tb) = o;
    }
}

template <class C>
__device__ void hyena_channel(const Params& p, LAS v2f* buf, LAS float* red, LAS unsigned short* stage, unsigned* ks, unsigned* zs, int lt_in, int Lsel, int c, bool do_store = true) {
    constexpr int N = C::N, L = N / 2, S1 = C::S1, NT = C::NT, NW = NT / 64;
    const bf16_t* CT = (const bf16_t*)(p.ws + OFF_CT);
    const float* SW = p.in[9]; const float* SB = p.in[10];
    const __half* hraw = (const __half*)(p.ws + OFF_HRAW) + (Lsel ? (size_t)2048 * 4096 : (size_t)0);
    bf16_t* ctw = (bf16_t*)(p.ws + OFF_CT);
#pragma unroll 1
    for (int o = 0; o < 2; ++o) {
#pragma unroll 1
        for (int st = 0; st < 3; ++st) {
            const int bb0 = Lsel * 4 + (st == 2 ? 2 : 0);
            const int rb0 = row_base(bb0), rb1 = row_base(bb0 + 1);
            const bf16_t* ct0 = CT + (size_t)rb0 * 2048; const bf16_t* ct1 = CT + (size_t)rb1 * 2048;
            unsigned* zp = zs + (st == 2 ? 16 * NT : 0);
            {
                const int lt = opaque_i(lt_in), lane = lt & 63, lw = lt >> 6;
                v2f v[32];
                if (st == 0) {
                    const __half* hf = hraw + (size_t)(o * 1024 + c) * L; const __half* hb = hf + (size_t)512 * L;
                    float sf = 0.f, sb = 0.f;
                    __half hr[32];
#pragma unroll
                    for (int j = 0; j < 16; ++j) hr[j] = hf[lt + j * S1];
#pragma unroll
                    for (int j = 16; j < 32; ++j) { const int idx = lt + j * S1; hr[j] = hb[N - idx == L ? 0 : N - idx]; }
                    __builtin_amdgcn_sched_barrier(0);
#pragma unroll
                    for (int j = 0; j < 16; ++j) { const float x = __half2float(hr[j]); v[j].x = x; v[j].y = 0.f; sf += fabsf(x); }
#pragma unroll
                    for (int j = 16; j < 32; ++j) { const int idx = lt + j * S1; const float x = __half2float(hr[j]); sb += fabsf(x);
                        v[j].x = (idx == L) ? 0.f : x; v[j].y = 0.f; }
                    sf = wave_sum(sf); sb = wave_sum(sb);
                    if (lane == 0) { red[lw * 2] = sf; red[lw * 2 + 1] = sb; }
                    __syncthreads();
                    float tf = 0.f, tb = 0.f;
#pragma unroll
                    for (int w = 0; w < NW; ++w) { tf += red[w * 2]; tb += red[w * 2 + 1]; }
                    const float isf = 1.0f / tf, isb = 1.0f / tb;
#pragma unroll
                    for (int j = 0; j < 16; ++j) v[j].x *= isf;
#pragma unroll
                    for (int j = 16; j < 32; ++j) v[j].x *= isb;
                } else {
                    if (o == 0) {
                        const float w0 = SW[c], w1 = SW[1536 + c], w2 = SW[3072 + c], b = SB[c];
                        stage_conv_row<NT, L>(ct0 + (size_t)c * L, lt, w0, w1, w2, b, stage);
                        __syncthreads();
#pragma unroll
                        for (int j = 0; j < 16; ++j) v[j].x = __half2float(__ushort_as_half(stage[lt + j * S1]));
                        __syncthreads();
                        stage_conv_row<NT, L>(ct1 + (size_t)c * L, lt, w0, w1, w2, b, stage);
                        __syncthreads();
#pragma unroll
                        for (int j = 0; j < 16; ++j) v[j].y = __half2float(__ushort_as_half(stage[lt + j * S1]));
                    } else {
#pragma unroll
                        for (int j = 0; j < 16; ++j) { const float2 zf = __half22float2(__builtin_bit_cast(__half2, zp[j * NT + lt])); v[j].x = zf.x; v[j].y = zf.y; }
                    }
#pragma unroll
                    for (int j = 16; j < 32; ++j) { v[j].x = 0.f; v[j].y = 0.f; }
                }
                pass1_fwd<C>(v, lt, buf);
            }
            __syncthreads();
            pass2<C, false>(opaque_i(lt_in), buf);
            __syncthreads();
            if (st == 0) { pass3_filter<C>(opaque_i(lt_in), buf, ks, p.in[19][o * 512 + c]); __syncthreads(); continue; }
            pass3_fused<C>(opaque_i(lt_in), buf, ks);
            __syncthreads();
            pass2<C, true>(opaque_i(lt_in), buf);
            __syncthreads();
            {
                const int lt = opaque_i(lt_in);
                const int ch = (o == 0 ? 512 : 1024) + c;
                const float w0 = SW[ch], w1 = SW[1536 + ch], w2 = SW[3072 + ch], b = SB[ch];
                v2f v[32];
                pass1_inv<C>(v, lt, buf);
                float yx[16], yy[16];
#pragma unroll
                for (int n1 = 0; n1 < 16; ++n1) { const v2f y = v[brev_c(n1, 5)] * (1.0f / (float)N); yx[n1] = y.x; yy[n1] = y.y; }
                stage_conv_row<NT, L>(ct0 + (size_t)ch * L, lt, w0, w1, w2, b, stage);
                __syncthreads();
#pragma unroll
                for (int n1 = 0; n1 < 16; ++n1) yx[n1] *= __half2float(__ushort_as_half(stage[lt + n1 * S1]));
                __syncthreads();
                stage_conv_row<NT, L>(ct1 + (size_t)ch * L, lt, w0, w1, w2, b, stage);
                __syncthreads();
#pragma unroll
                for (int n1 = 0; n1 < 16; ++n1) yy[n1] *= __half2float(__ushort_as_half(stage[lt + n1 * S1]));
#pragma unroll
                for (int n1 = 0; n1 < 16; ++n1) { const int t = lt + n1 * S1;
                    if (o == 0) { zp[n1 * NT + lt] = __builtin_bit_cast(unsigned, __floats2half2_rn(yx[n1], yy[n1])); }
                    else if (do_store) { ctw[(size_t)rb0 * 2048 + (size_t)c * L + t] = f2bf(yx[n1]); ctw[(size_t)rb1 * 2048 + (size_t)c * L + t] = f2bf(yy[n1]); } }
            }
            __syncthreads();
        }
    }
}

__device__ __forceinline__ char* sbuf_addr(const Params& p, int unit, int e, int dp) { return (char*)p.out + ((size_t)unit * 32 + (e >> 2)) * 4096 + 2048 + (e & 3) * 512 + dp * 2; }

__device__ void ret_state_unit(const Params& p, int unit, LAS unsigned char* lds) {
    const int h = unit & 3, gc = unit >> 2, r0 = gc * 128; int rb, L; row_info(r0, rb, L); const int t0 = r0 - rb;
    const bf16_t* Kk = (const bf16_t*)(p.ws + OFF_K) + (size_t)r0 * 512 + h * 128;
    const bf16_t* vT = (const bf16_t*)(p.ws + OFF_CT) + (size_t)rb * 2048 + (size_t)(1536 + h * 128) * L + t0;
    const int tid = opaque_i(threadIdx.x), wid = tid >> 6, lane = tid & 63, lr = lane & 15, lq = lane >> 4;
    LAS unsigned char* lK = lds; LAS unsigned char* lV = lds + 34816;
    {
        u32x4 rk[4], rv[4];
#pragma unroll
        for (int i = 0; i < 4; ++i) { const int q = tid + i * 512, row = q >> 4, c16 = q & 15;
            const int jr = q & 127, dc = q >> 7;
            rk[i] = *(const u32x4*)(Kk + (size_t)jr * 512 + dc * 8); rv[i] = *(const u32x4*)(vT + (size_t)row * L + c16 * 8); }
#pragma unroll
        for (int i = 0; i < 4; ++i) { const int q = tid + i * 512, row = q >> 4, c16 = q & 15;
            const int jr = q & 127, dc = q >> 7;
            LAS unsigned short* kt = (LAS unsigned short*)(lK + (dc * 8) * 272 + jr * 2);
            kt[0 * 136] = (unsigned short)(rk[i].x & 0xffffu); kt[1 * 136] = (unsigned short)(rk[i].x >> 16);
            kt[2 * 136] = (unsigned short)(rk[i].y & 0xffffu); kt[3 * 136] = (unsigned short)(rk[i].y >> 16);
            kt[4 * 136] = (unsigned short)(rk[i].z & 0xffffu); kt[5 * 136] = (unsigned short)(rk[i].z >> 16);
            kt[6 * 136] = (unsigned short)(rk[i].w & 0xffffu); kt[7 * 136] = (unsigned short)(rk[i].w >> 16);
            *(LAS u32x4*)(lV + row * 272 + c16 * 16) = rv[i]; }
    }
    __syncthreads();
    const bool bwd = wid >= 4;
    const float lg = bwd ? p.in[21][h] : p.in[20][h];
    f32x4 acc[2][8];
#pragma unroll
    for (int a = 0; a < 2; ++a)
#pragma unroll
        for (int b = 0; b < 8; ++b) acc[a][b] = (f32x4){0.f, 0.f, 0.f, 0.f};
#pragma unroll
    for (int ks = 0; ks < 4; ++ks) {
        const int j0 = 32 * ks + lq * 8;
        float wk[8];
#pragma unroll
        for (int i = 0; i < 8; ++i) { const int j = j0 + i; wk[i] = __expf(lg * (float)(bwd ? j : 127 - j)); }
        bf16x8 a[2];
#pragma unroll
        for (int mt = 0; mt < 2; ++mt) { const int d = (32 * wid + 16 * mt + lr) & 127;
            const u32x4 raw = *(const LAS u32x4*)(lK + d * 272 + j0 * 2);
            u32x4 w;
            w.x = pack_bf(bflo(raw.x) * wk[0], bfhi(raw.x) * wk[1]); w.y = pack_bf(bflo(raw.y) * wk[2], bfhi(raw.y) * wk[3]);
            w.z = pack_bf(bflo(raw.z) * wk[4], bfhi(raw.z) * wk[5]); w.w = pack_bf(bflo(raw.w) * wk[6], bfhi(raw.w) * wk[7]);
            a[mt] = __builtin_bit_cast(bf16x8, w); }
#pragma unroll
        for (int nt = 0; nt < 8; ++nt) { const int e = 16 * nt + lr;
            const bf16x8 b = *(const LAS bf16x8*)(lV + e * 272 + j0 * 2);
#pragma unroll
            for (int mt = 0; mt < 2; ++mt) acc[mt][nt] = __builtin_amdgcn_mfma_f32_16x16x32_bf16(a[mt], b, acc[mt][nt], 0, 0, 0); }
        __builtin_amdgcn_sched_barrier(0);
    }
#pragma unroll
    for (int mt = 0; mt < 2; ++mt)
#pragma unroll
        for (int nt = 0; nt < 8; ++nt) { const int dp = 32 * wid + 16 * mt + lq * 4, e = 16 * nt + lr;
            u32x2 w; w.x = pack_bf(acc[mt][nt][0], acc[mt][nt][1]); w.y = pack_bf(acc[mt][nt][2], acc[mt][nt][3]);
            *(u32x2*)sbuf_addr(p, unit, e, dp) = w; }
    __syncthreads();
}

__device__ void ret_scan(const Params& p) {
#pragma unroll 1
    for (int gid = blockIdx.x * 512 + threadIdx.x; gid < 131072; gid += gridDim.x * 512) {
    const int dg = gid & 31, e = (gid >> 5) & 127, h = (gid >> 12) & 3, bb = gid >> 14;
    const bool bwd = dg >= 16;
    const float gC = __expf(128.0f * (bwd ? p.in[21][h] : p.in[20][h]));
    const int nc = bb < 4 ? 32 : 64, gc0 = row_base(bb) / 128;
    float run[8];
#pragma unroll
    for (int i = 0; i < 8; ++i) run[i] = 0.f;
#pragma unroll 1
    for (int it = 0; it < nc; it += 4) {
        u32x4 s[4]; char* ad[4];
#pragma unroll
        for (int q = 0; q < 4; ++q) { const int n = bwd ? (nc - 1 - it - q) : (it + q); ad[q] = sbuf_addr(p, (gc0 + n) * 4 + h, e, dg * 8); s[q] = *(const u32x4*)ad[q]; }
#pragma unroll
        for (int q = 0; q < 4; ++q) {
            u32x4 w; w.x = pack_bf(run[0], run[1]); w.y = pack_bf(run[2], run[3]); w.z = pack_bf(run[4], run[5]); w.w = pack_bf(run[6], run[7]);
            *(u32x4*)ad[q] = w;
            run[0] = gC * run[0] + bflo(s[q].x); run[1] = gC * run[1] + bfhi(s[q].x); run[2] = gC * run[2] + bflo(s[q].y); run[3] = gC * run[3] + bfhi(s[q].y);
            run[4] = gC * run[4] + bflo(s[q].z); run[5] = gC * run[5] + bfhi(s[q].z); run[6] = gC * run[6] + bflo(s[q].w); run[7] = gC * run[7] + bfhi(s[q].w);
        }
    }
    }
}

__device__ void ret_out_unit(const Params& p, int unit, LAS unsigned char* lds, bool do_store = true) {
    const int h = unit & 3, gc = unit >> 2, r0 = gc * 128; int rb, L; row_info(r0, rb, L); const int t0 = r0 - rb;
    bf16_t* Q = (bf16_t*)(p.ws + OFF_Q) + (size_t)r0 * 512 + h * 128;
    const bf16_t* Kk = (const bf16_t*)(p.ws + OFF_K) + (size_t)r0 * 512 + h * 128;
    const bf16_t* SG = (const bf16_t*)(p.ws + OFF_SG) + (size_t)r0 * 512 + h * 128;
    const bf16_t* vT = (const bf16_t*)(p.ws + OFF_CT) + (size_t)rb * 2048 + (size_t)(1536 + h * 128) * L + t0;
    const int tid = opaque_i(threadIdx.x), wid = tid >> 6, lane = tid & 63, lr = lane & 15, lq = lane >> 4;
    const float lgf = p.in[20][h], lgb = p.in[21][h];
    LAS unsigned char* lK = lds;
    LAS unsigned char* lV = lds + 34816;
    LAS unsigned char* lR = lds + 69632;
    bf16x8 qa[4];
    {
        u32x4 rr[8];
#pragma unroll
        for (int i = 0; i < 8; ++i) { const int q = tid + i * 512, row = q >> 5, c16 = q & 31; rr[i] = *(const u32x4*)sbuf_addr(p, unit, row, c16 * 8); }
#pragma unroll
        for (int i = 0; i < 8; ++i) { const int q = tid + i * 512, row = q >> 5, c16 = q & 31; *(LAS u32x4*)(lR + row * 528 + c16 * 16) = rr[i]; }
    }
    {
        u32x4 rk[4], rv[4];
#pragma unroll
        for (int i = 0; i < 4; ++i) { const int q = tid + i * 512, row = q >> 4, c16 = q & 15;
            rk[i] = *(const u32x4*)(Kk + (size_t)row * 512 + c16 * 8); rv[i] = *(const u32x4*)(vT + (size_t)row * L + c16 * 8); }
#pragma unroll
        for (int ks = 0; ks < 4; ++ks) qa[ks] = *(const bf16x8*)(Q + (size_t)(16 * wid + lr) * 512 + 32 * ks + lq * 8);
#pragma unroll
        for (int i = 0; i < 4; ++i) { const int q = tid + i * 512, row = q >> 4, c16 = q & 15;
            *(LAS u32x4*)(lK + row * 272 + c16 * 16) = rk[i]; *(LAS u32x4*)(lV + row * 272 + c16 * 16) = rv[i]; }
    }
    __syncthreads();
    f32x4 s[8];
#pragma unroll
    for (int nt = 0; nt < 8; ++nt) { s[nt] = (f32x4){0.f, 0.f, 0.f, 0.f};
#pragma unroll
        for (int ks = 0; ks < 4; ++ks) { const bf16x8 b = *(const LAS bf16x8*)(lK + (16 * nt + lr) * 272 + (32 * ks + lq * 8) * 2);
            s[nt] = __builtin_amdgcn_mfma_f32_16x16x32_bf16(qa[ks], b, s[nt], 0, 0, 0); }
        __builtin_amdgcn_sched_barrier(0); }
    __syncthreads();
    LAS bf16_t* Pw = (LAS bf16_t*)lK + wid * (16 * 136);
#pragma unroll
    for (int nt = 0; nt < 8; ++nt)
#pragma unroll
        for (int r = 0; r < 4; ++r) { const int i = 16 * wid + lq * 4 + r, j = 16 * nt + lr, diff = i - j;
            const float D = diff >= 0 ? __expf(lgf * (float)diff) : __expf(lgb * (float)(-diff));
            Pw[(lq * 4 + r) * 136 + j] = f2bf(s[nt][r] * D); }
    __syncthreads();
    bf16x8 pa[4];
#pragma unroll
    for (int ks = 0; ks < 4; ++ks) pa[ks] = *(const LAS bf16x8*)(Pw + lr * 136 + 32 * ks + lq * 8);
    f32x4 o1[8], of[8], ob[8];
#pragma unroll
    for (int nt = 0; nt < 8; ++nt) { const int e = 16 * nt + lr;
        o1[nt] = (f32x4){0.f, 0.f, 0.f, 0.f}; of[nt] = o1[nt]; ob[nt] = o1[nt];
#pragma unroll
        for (int ks = 0; ks < 4; ++ks) {
            const bf16x8 bv = *(const LAS bf16x8*)(lV + e * 272 + (32 * ks + lq * 8) * 2);
            o1[nt] = __builtin_amdgcn_mfma_f32_16x16x32_bf16(pa[ks], bv, o1[nt], 0, 0, 0);
            const bf16x8 bf = *(const LAS bf16x8*)(lR + e * 528 + (32 * ks + lq * 8) * 2);
            of[nt] = __builtin_amdgcn_mfma_f32_16x16x32_bf16(qa[ks], bf, of[nt], 0, 0, 0);
            const bf16x8 bb = *(const LAS bf16x8*)(lR + e * 528 + 256 + (32 * ks + lq * 8) * 2);
            ob[nt] = __builtin_amdgcn_mfma_f32_16x16x32_bf16(qa[ks], bb, ob[nt], 0, 0, 0); }
        __builtin_amdgcn_sched_barrier(0); }
    __syncthreads();
    {
        u32x4 rg[4];
#pragma unroll
        for (int i = 0; i < 4; ++i) { const int q = tid + i * 512, row = q >> 4, c16 = q & 15; rg[i] = *(const u32x4*)(SG + (size_t)row * 512 + c16 * 8); }
#pragma unroll
        for (int i = 0; i < 4; ++i) { const int q = tid + i * 512, row = q >> 4, c16 = q & 15; *(LAS u32x4*)(lK + row * 272 + c16 * 16) = rg[i]; }
    }
    __syncthreads();
#pragma unroll
    for (int r = 0; r < 4; ++r) { const int i = 16 * wid + lq * 4 + r;
        const float wqf = __expf(lgf * (float)(i + 1)), wqb = __expf(lgb * (float)(128 - i));
        float ov[8]; float ss = 0.f;
#pragma unroll
        for (int nt = 0; nt < 8; ++nt) { const float o = o1[nt][r] + wqf * of[nt][r] + wqb * ob[nt][r]; ov[nt] = o; ss += o * o; }
        ss += __shfl_xor(ss, 1); ss += __shfl_xor(ss, 2); ss += __shfl_xor(ss, 4); ss += __shfl_xor(ss, 8);
        const float rs = rsqrtf(ss * (1.0f / 128.0f) + 1e-6f);
#pragma unroll
        for (int nt = 0; nt < 8; ++nt) { const int e = 16 * nt + lr; const float g = bf2f(*(const LAS bf16_t*)(lK + i * 272 + e * 2));
            *(LAS bf16_t*)(lV + i * 272 + e * 2) = f2bf(ov[nt] * rs * g); }
        __builtin_amdgcn_sched_barrier(0); }
    __syncthreads();
    if (do_store) {
#pragma unroll
        for (int i = 0; i < 4; ++i) { const int q = tid + i * 512, row = q >> 4, c16 = q & 15;
            *(u32x4*)(Q + (size_t)row * 512 + c16 * 8) = *(const LAS u32x4*)(lV + row * 272 + c16 * 16); }
    }
    __syncthreads();
}

__device__ void yh_transpose_tile(const Params& p, int tile, LAS bf16_t* lt_) {
    const int ctile = tile & 7, ttile = tile >> 3;
    const int r0 = ttile * 256; int rb, L; row_info(r0, rb, L);
    const bf16_t* src = (const bf16_t*)(p.ws + OFF_CT) + (size_t)rb * 2048 + (size_t)(ctile * 64) * L + (r0 - rb);
    bf16_t* dst = (bf16_t*)(p.ws + OFF_KT) + (size_t)r0 * 512 + ctile * 64;
    const int tid = opaque_i(threadIdx.x);
    u32x4 w[4];
#pragma unroll
    for (int i = 0; i < 4; ++i) { const int q = tid + i * 512, a = q >> 5, b8 = (q & 31) * 8; w[i] = *(const u32x4*)(src + (size_t)a * L + b8); }
#pragma unroll
    for (int i = 0; i < 4; ++i) { const int q = tid + i * 512, a = q >> 5, b8 = (q & 31) * 8;
        lt_[(b8 + 0) * 66 + a] = (bf16_t)(w[i].x & 0xffffu); lt_[(b8 + 1) * 66 + a] = (bf16_t)(w[i].x >> 16);
        lt_[(b8 + 2) * 66 + a] = (bf16_t)(w[i].y & 0xffffu); lt_[(b8 + 3) * 66 + a] = (bf16_t)(w[i].y >> 16);
        lt_[(b8 + 4) * 66 + a] = (bf16_t)(w[i].z & 0xffffu); lt_[(b8 + 5) * 66 + a] = (bf16_t)(w[i].z >> 16);
        lt_[(b8 + 6) * 66 + a] = (bf16_t)(w[i].w & 0xffffu); lt_[(b8 + 7) * 66 + a] = (bf16_t)(w[i].w >> 16); }
    __syncthreads();
#pragma unroll
    for (int i = 0; i < 4; ++i) { const int q = tid + i * 512, a = q >> 3, b8 = (q & 7) * 8;
        u32x4 o;
        o.x = (unsigned)lt_[a * 66 + b8 + 0] | ((unsigned)lt_[a * 66 + b8 + 1] << 16); o.y = (unsigned)lt_[a * 66 + b8 + 2] | ((unsigned)lt_[a * 66 + b8 + 3] << 16);
        o.z = (unsigned)lt_[a * 66 + b8 + 4] | ((unsigned)lt_[a * 66 + b8 + 5] << 16); o.w = (unsigned)lt_[a * 66 + b8 + 6] | ((unsigned)lt_[a * 66 + b8 + 7] << 16);
        *(u32x4*)(dst + (size_t)a * 512 + b8) = o; }
    __syncthreads();
}

#define XB_TMO      128
#define XB_XCNT(j)  (256  + 64 * (j))
#define XB_XSUB(j)  (1280 + 64 * (j))
#define XB_XGEN(j)  (2304 + 64 * (j))
#define XB_TOP      3328
#define XB_TOPGEN   3392
#define XCD_BAR_WORDS 3456
#define XB_SPIN_CAP (1u << 18)

__device__ __forceinline__ unsigned xb_ld(unsigned* p)              { return __hip_atomic_load(p, __ATOMIC_RELAXED, __HIP_MEMORY_SCOPE_AGENT); }
__device__ __forceinline__ unsigned xb_add(unsigned* p, unsigned v) { return __hip_atomic_fetch_add(p, v, __ATOMIC_RELAXED, __HIP_MEMORY_SCOPE_AGENT); }
__device__ __forceinline__ unsigned xb_xcc_id() { return (unsigned)__builtin_amdgcn_s_getreg((3 << 11) | 20) & 0xFu; }
#define XB_SPIN(cond, bar) do { unsigned _sp = 0; while (cond) { __builtin_amdgcn_s_sleep(1); \
    if ((++_sp & 255u) == 0u) { if (xb_ld(&(bar)[XB_TMO])) break; if (_sp > XB_SPIN_CAP) { atomicAdd(&(bar)[XB_TMO], 1u); break; } } } } while (0)

struct XcdBarrier {
    unsigned* bar; unsigned x;
    volatile LAS unsigned* st;
};

__device__ __forceinline__ XcdBarrier xcd_barrier_post(unsigned* bar, volatile LAS unsigned* st) {
    XcdBarrier b; b.bar = bar; b.x = xb_xcc_id(); b.st = st;
    if (threadIdx.x == 0) (void)xb_add(&bar[XB_XCNT(b.x)], 1u);
    return b;
}
__device__ __forceinline__ void xcd_barrier_complete(unsigned* bar, unsigned x, unsigned& nloc, unsigned& nx) {
    const unsigned G = gridDim.x * gridDim.y * gridDim.z;
    unsigned sum, cnt, mine, sp = 0u;
    for (;;) {
        sum = 0u; cnt = 0u; mine = 0u;
#pragma unroll
        for (unsigned j = 0; j < 16; ++j) { const unsigned c = xb_ld(&bar[XB_XCNT(j)]); sum += c; cnt += (c > 0u) ? 1u : 0u; mine = (j == x) ? c : mine; }
        if (sum == G) break;
        __builtin_amdgcn_s_sleep(1);
        if ((++sp & 255u) == 0u) { if (xb_ld(&bar[XB_TMO])) break; if (sp > XB_SPIN_CAP) { atomicAdd(&bar[XB_TMO], 1u); break; } }
    }
    nloc = mine > 0u ? mine : 1u; nx = cnt > 0u ? cnt : 1u;
}

__device__ __forceinline__ void xcd_barrier(const XcdBarrier& b) {
    asm volatile("s_waitcnt vmcnt(0)" ::: "memory");
    __syncthreads();
    if (threadIdx.x == 0) {
        unsigned* bar = b.bar;
        __builtin_amdgcn_s_waitcnt(0);
        unsigned nloc = b.st[0], nx = b.st[1];
        if (nloc == 0u) { xcd_barrier_complete(bar, b.x, nloc, nx); b.st[0] = nloc; b.st[1] = nx; }
        const unsigned old = xb_add(&bar[XB_XSUB(b.x)], 1u);
        const unsigned gen = old / nloc;
        if (old + 1u == (gen + 1u) * nloc) {
            __builtin_amdgcn_fence(__ATOMIC_RELEASE, "agent");
            asm volatile("s_waitcnt vmcnt(0)" ::: "memory");
            const unsigned og = xb_add(&bar[XB_TOP], 1u);
            const unsigned tg = og / nx;
            if (og + 1u == (tg + 1u) * nx) xb_add(&bar[XB_TOPGEN], 1u);
            else XB_SPIN(xb_ld(&bar[XB_TOPGEN]) == tg, bar);
            __builtin_amdgcn_fence(__ATOMIC_ACQUIRE, "agent");
            xb_add(&bar[XB_XGEN(b.x)], 1u);
            asm volatile("s_waitcnt vmcnt(0)" ::: "memory");
        } else {
            XB_SPIN(xb_ld(&bar[XB_XGEN(b.x)]) == gen, bar);
            __builtin_amdgcn_fence(__ATOMIC_ACQUIRE, "agent");
            asm volatile("s_waitcnt vmcnt(0)" ::: "memory");
        }
    }
    __syncthreads();
}


__device__ __attribute__((noinline)) void xcd_barrier_call(unsigned* bar, unsigned x, volatile LAS unsigned* st) { XcdBarrier b; b.bar = bar; b.x = x; b.st = st; xcd_barrier(b); }

typedef FftCfg<32, 32, 16, 512> CfgBig;
typedef FftCfg<32, 16, 16, 256> CfgSmall;

#define PHASE_SYNC() do { if (ph_hi - ph_lo > 1) xcd_barrier_call(xb.bar, xb.x, xb.st); } while (0)
#ifndef HY_REP
#define HY_REP 1
#endif
#ifndef DUP_MASK
#define DUP_MASK 0
#endif
#ifndef PHASE_MASK
#define PHASE_MASK 0x1fff
#endif
#define RUN(ph) (((PHASE_MASK >> (ph)) & 1) && ph_lo <= (ph) && (ph) < ph_hi)

__global__ void __launch_bounds__(512, 2) hybrid_forward(Params p) {
    cg::grid_group grid = cg::this_grid();
    extern __shared__ __attribute__((aligned(16))) unsigned char smem[];
    LAS unsigned char* lds = (LAS unsigned char*)smem;
    const int ph_lo = p.ph_lo, ph_hi = p.ph_hi;
    const int tid = threadIdx.x;
    bf16_t* slotB = (bf16_t*)((char*)p.out + 2048);
    pg8::StaticOrder S;
    volatile LAS unsigned* xb_words = (volatile LAS unsigned*)(lds + SMEM_BYTES);
    if (tid < 4) xb_words[tid] = 0u;
    __syncthreads();
    XcdBarrier xb = xcd_barrier_post((unsigned*)(p.ws + OFF_BAR), xb_words);

    if (RUN(0)) { auto phf = [&]() {
        phase0_transposes(p, (LAS float*)lds);
        phase0_rot(p);
        for (int u = blockIdx.x; u < 192 * REP_FILT; u += gridDim.x) filter_unit(p, u % 192, lds);
        row_phase<0>(p, p.in[2], nullptr, REP_ROW0);
    }; phf(); if ((DUP_MASK >> 0) & 1) phf(); }
    if (ph_lo < 1 && ph_hi > 1) grid.sync();
    if (RUN(1)) { auto phf = [&]() {
        pg8::Gemm g{slotB, (const bf16_t*)(p.ws + OFF_WUP1), T_ALL, 5632, 1024, 2048, 1024, 1 << 30, 0l};
        S.init(g.M, g.N, gridDim.x, blockIdx.x);
        pg8::gemm_phase(lds, g, S, pg8::EpiSwiglu{(bf16_t*)(p.ws + OFF_G), 2816});
    }; phf(); if ((DUP_MASK >> 1) & 1) phf(); }
    if (ph_lo < 2 && ph_hi > 2) PHASE_SYNC();
    if (RUN(2)) { auto phf = [&]() {
        pg8::Gemm g{(const bf16_t*)(p.ws + OFF_G), (const bf16_t*)(p.ws + OFF_WDN1), T_ALL, 1024, 2816, 2816, 2816, 1 << 30, 0l};
        S.init(g.M, g.N, gridDim.x, blockIdx.x);
        pg8::gemm_phase(lds, g, S, pg8::EpiBf16{slotB, 2048});
    }; phf(); if ((DUP_MASK >> 2) & 1) phf(); }
    if (ph_lo < 3 && ph_hi > 3) { PHASE_SYNC();
#pragma unroll 1
        for (int rep = 0; rep < EXTRA_SYNCS; ++rep) xcd_barrier_call(xb.bar, xb.x, xb.st); }
    if (RUN(3)) { auto phf = [&]() { row_phase<1>(p, p.in[6], p.in[7]); }; phf(); if ((DUP_MASK >> 3) & 1) phf(); }
    if (ph_lo < 4 && ph_hi > 4) PHASE_SYNC();
    if (RUN(4)) { auto phf = [&]() {
        {
            pg8::Gemm g{(const bf16_t*)(p.ws + OFF_WIN), slotB, 2048, T_ALL, 1024, 1024, 2048, 1 << 30, 0l};
            S.init(g.M, g.N, gridDim.x, blockIdx.x);
            pg8::gemm_phase(lds, g, S, pg8::EpiCT{(bf16_t*)(p.ws + OFF_CT)});
        }
        {
            pg8::Gemm g{slotB, (const bf16_t*)(p.ws + OFF_WIN) + (size_t)2048 * 1024, T_ALL, 1536, 1024, 2048, 1024, 1 << 30, 0l};
            S.init(g.M, g.N, gridDim.x, (blockIdx.x + gridDim.x / 2) % gridDim.x);
            pg8::gemm_phase(lds, g, S, pg8::EpiQKG{(bf16_t*)(p.ws + OFF_Q), (bf16_t*)(p.ws + OFF_K), (bf16_t*)(p.ws + OFF_SG), (const v2f*)(p.ws + OFF_ROT)});
        }
    }; phf(); if ((DUP_MASK >> 4) & 1) phf(); }
    if (ph_lo < 5 && ph_hi > 5) PHASE_SYNC();
    if (RUN(5)) { auto phf = [&]() { for (int u = blockIdx.x; u < 1536 * REP5; u += gridDim.x) ret_state_unit(p, u % 1536, lds); }; phf(); if ((DUP_MASK >> 5) & 1) phf(); }
    if (ph_lo < 6 && ph_hi > 6) PHASE_SYNC();
    int rep6 = 0;
    if (RUN(6)) { auto phf = [&]() {
        if (rep6++ == 0) ret_scan(p);
        LAS v2f* buf = (LAS v2f*)lds; LAS float* red = (LAS float*)(lds + FFT_BYTES); LAS unsigned short* stg = (LAS unsigned short*)(lds + FFT_BYTES + 1024);
        unsigned* zscr = (unsigned*)(p.ws + WS_END) + (size_t)blockIdx.x * 16384;
        unsigned* kscr = (unsigned*)(p.ws + OFF_WUP1) + (size_t)blockIdx.x * 16384;
        for (int u = blockIdx.x; u < 512 * HY_REP; u += gridDim.x) hyena_channel<CfgBig>(p, buf, red, stg, kscr, zscr, tid, 1, u & 511, u >= 512 * (HY_REP - 1));
        for (int u = blockIdx.x; u < 256 * HY_REP; u += gridDim.x) { const int hb = tid >> 8; hyena_channel<CfgSmall>(p, buf + hb * CfgSmall::PHYS, red + hb * 32, stg + hb * 4096, kscr + hb * 8192, zscr + hb * 8192, tid & 255, 0, (u & 255) * 2 + hb, u >= 256 * (HY_REP - 1)); }
    }; phf(); if ((DUP_MASK >> 6) & 1) phf(); }
    if (ph_lo < 7 && ph_hi > 7) PHASE_SYNC();
    if (RUN(7)) { auto phf = [&]() { for (int u = blockIdx.x; u < 1536 * REP7; u += gridDim.x) ret_out_unit(p, u % 1536, lds, u >= 1536 * (REP7 - 1));
        for (int u = blockIdx.x; u < 1536; u += gridDim.x) yh_transpose_tile(p, u, (LAS bf16_t*)lds); }; phf(); if ((DUP_MASK >> 7) & 1) phf(); }
    if (ph_lo < 8 && ph_hi > 8) PHASE_SYNC();
    if (RUN(8)) { auto phf = [&]() {
        pg8::Gemm g{(const bf16_t*)(p.ws + OFF_KT), (const bf16_t*)(p.ws + OFF_WOUT), T_ALL, 1024, 1024, 512, 1024, 8, (long)OFF_Q - (long)OFF_KT - 8 * 128};
        S.init(g.M, g.N, gridDim.x, blockIdx.x);
        pg8::gemm_phase(lds, g, S, pg8::EpiBf16{slotB, 2048});
    }; phf(); if ((DUP_MASK >> 8) & 1) phf(); }
    if (ph_lo < 9 && ph_hi > 9) PHASE_SYNC();
    if (RUN(9)) { auto phf = [&]() { row_phase<2>(p, p.in[23], p.in[24]); }; phf(); if ((DUP_MASK >> 9) & 1) phf(); }
    if (ph_lo < 10 && ph_hi > 10) PHASE_SYNC();
    if (RUN(10)) { auto phf = [&]() {
        pg8::Gemm g{slotB, (const bf16_t*)(p.ws + OFF_WUP2), T_ALL, 5632, 1024, 2048, 1024, 1 << 30, 0l};
        S.init(g.M, g.N, gridDim.x, blockIdx.x);
        pg8::gemm_phase(lds, g, S, pg8::EpiSwiglu{(bf16_t*)(p.ws + OFF_G), 2816});
    }; phf(); if ((DUP_MASK >> 10) & 1) phf(); }
    if (ph_lo < 11 && ph_hi > 11) PHASE_SYNC();
    if (RUN(11)) { auto phf = [&]() {
        pg8::Gemm g{(const bf16_t*)(p.ws + OFF_G), (const bf16_t*)(p.ws + OFF_WDN2), T_ALL, 1024, 2816, 2816, 2816, 1 << 30, 0l};
        S.init(g.M, g.N, gridDim.x, blockIdx.x);
        pg8::gemm_phase(lds, g, S, pg8::EpiBf16{slotB, 2048});
    }; phf(); if ((DUP_MASK >> 11) & 1) phf(); }
    if (ph_lo < 12 && ph_hi > 12) PHASE_SYNC();
    if (RUN(12)) { auto phf = [&]() { row_phase<3>(p, p.in[28], nullptr); }; phf(); if ((DUP_MASK >> 12) & 1) phf(); }
}

#ifndef MULTI_LAUNCH
#define MULTI_LAUNCH 0
#endif
extern "C" void kernel_launch(void* const* d_in, const int* in_sizes, int n_in, void* d_out, int out_size, void* d_ws, size_t ws_size, hipStream_t stream) {
    static int grid_blocks = 0;
    if (!grid_blocks) {
        hipFuncSetAttribute((const void*)hybrid_forward, hipFuncAttributeMaxDynamicSharedMemorySize, SMEM_BYTES + 16);
        int dev = 0, cus = 0, per_cu = 0;
        hipGetDevice(&dev);
        hipDeviceGetAttribute(&cus, hipDeviceAttributeMultiprocessorCount, dev);
        hipOccupancyMaxActiveBlocksPerMultiprocessor(&per_cu, hybrid_forward, 512, SMEM_BYTES + 16);
        grid_blocks = cus * per_cu;
        if (grid_blocks <= 0 || grid_blocks > 256) grid_blocks = 256;
    }
    Params p{};
    for (int i = 0; i < 29; ++i) p.in[i] = (const float*)d_in[i];
    p.out = (float*)d_out; p.ws = (char*)d_ws;
#if MULTI_LAUNCH
    for (int ph = 0; ph < 13; ++ph) { p.ph_lo = ph; p.ph_hi = ph + 1; hipLaunchKernelGGL(hybrid_forward, dim3(256), dim3(512), 0, stream, p); }
#else
    p.ph_lo = 0; p.ph_hi = 13;
    hipMemsetAsync((char*)d_ws + OFF_BAR, 0, XCD_BAR_WORDS * 4, stream);
    void* args[] = {&p};
    hipError_t e = hipLaunchCooperativeKernel((void*)hybrid_forward, dim3(grid_blocks), dim3(512), args, SMEM_BYTES + 16, stream);
    if (e != hipSuccess) fprintf(stderr, "cooperative launch failed: %s\n", hipGetErrorString(e));
#endif
}
```

```cpp
#include <hip/hip_runtime.h>
#include <hip/hip_fp16.h>
#include <hip/hip_cooperative_groups.h>
#include <cstdio>
namespace cg = cooperative_groups;

#define LAS __attribute__((address_space(3)))
typedef unsigned short bf16_t;
typedef short bf16x8 __attribute__((ext_vector_type(8)));
typedef float f32x4 __attribute__((ext_vector_type(4)));
typedef float v2f __attribute__((ext_vector_type(2)));
typedef unsigned u32x4 __attribute__((ext_vector_type(4)));
typedef unsigned u32x2 __attribute__((ext_vector_type(2)));

#ifndef EXTRA_SYNCS
#define EXTRA_SYNCS 0
#endif
#ifndef REP7
#define REP7 1
#endif
#ifndef REP5
#define REP5 1
#endif
#ifndef REP_TR
#define REP_TR 1
#endif
#ifndef REP_FILT
#define REP_FILT 1
#endif
#ifndef REP_ROW0
#define REP_ROW0 1
#endif
constexpr int T_ALL = 49152, T_P = 16384;
constexpr size_t U_BYTES = (size_t)T_ALL * 1024 * 2;
constexpr size_t SZ_WUP = (size_t)5632 * 1024 * 2, SZ_WDN = (size_t)1024 * 2816 * 2, SZ_WIN = (size_t)4096 * 1024 * 2, SZ_WOUT = (size_t)1024 * 1024 * 2;
constexpr size_t SZ_ROT = (size_t)8192 * 64 * 8, SZ_HRAW = (size_t)2048 * 12288 * 2;
constexpr size_t OFF_WUP1 = 0, OFF_WDN1 = OFF_WUP1 + SZ_WUP, OFF_WIN = OFF_WDN1 + SZ_WDN, OFF_WOUT = OFF_WIN + SZ_WIN, OFF_WUP2 = OFF_WOUT + SZ_WOUT,
                 OFF_WDN2 = OFF_WUP2 + SZ_WUP, OFF_ROT = OFF_WDN2 + SZ_WDN, OFF_ROTT = OFF_ROT + SZ_ROT, OFF_HRAW = OFF_ROTT + SZ_ROT, OFF_BIG = OFF_HRAW + SZ_HRAW;
constexpr size_t OFF_G = OFF_BIG;
constexpr size_t OFF_CT = OFF_BIG;
constexpr size_t OFF_Q = OFF_CT + 2 * U_BYTES;
constexpr size_t OFF_K = OFF_Q + U_BYTES / 2;
constexpr size_t OFF_SG = OFF_K + U_BYTES / 2;
constexpr size_t OFF_KT = OFF_SG + U_BYTES / 2;
constexpr size_t WS_END = OFF_KT + U_BYTES / 2;
static_assert(WS_END + (size_t)256 * 65536 + 16384 <= (size_t)536870912, "workspace");
constexpr size_t OFF_BAR = WS_END + (size_t)256 * 65536;
constexpr int FFT_BYTES = 143360;
constexpr int SMEM_BYTES = FFT_BYTES + 1024 + 16384;

struct Params {
    const float* in[29];
    float* out;
    char* ws;
    int ph_lo, ph_hi;
};

__device__ __forceinline__ unsigned short f2bf(float f) { unsigned u = __float_as_uint(f); u += 0x7fffu + ((u >> 16) & 1u); return (unsigned short)(u >> 16); }
__device__ __forceinline__ float bf2f(unsigned short h) { return __uint_as_float(((unsigned)h) << 16); }
__device__ __forceinline__ unsigned pack_bf(float lo, float hi) { unsigned r; asm("v_cvt_pk_bf16_f32 %0, %1, %2" : "=v"(r) : "v"(lo), "v"(hi)); return r; }
__device__ __forceinline__ float bflo(unsigned w) { return __uint_as_float(w << 16); }
__device__ __forceinline__ float bfhi(unsigned w) { return __uint_as_float(w & 0xffff0000u); }
__device__ __forceinline__ int row_base(int bb) { return bb < 4 ? bb * 4096 : 16384 + (bb - 4) * 8192; }
__device__ __forceinline__ void row_info(int r, int& rb, int& L) { if (r < T_P) { L = 4096; rb = r & ~4095; } else { L = 8192; rb = T_P + ((r - T_P) & ~8191); } }
__device__ __forceinline__ float wave_sum(float v) {
#pragma unroll
    for (int o = 32; o; o >>= 1) v += __shfl_xor(v, o);
    return v;
}
__device__ __forceinline__ float silu_f(float x) { return x * __builtin_amdgcn_rcpf(1.0f + __builtin_amdgcn_exp2f(x * -1.4426950408889634f)); }
namespace pg8 {
constexpr int BM = 256, BK = 64, HALF = 128, HTB = HALF * BK * 2, STAGE_BYTES = 8 * HTB, NXCD = 8, WGM = 8;
__device__ __forceinline__ int lds_byte(int r, int c) { const int st = (r >> 4) * 2 + (c >> 5), rr = r & 15, cc = c & 31, ob = rr * 64 + cc * 2; return st * 1024 + (ob ^ (((ob >> 9) & 1) << 5)); }
__device__ __forceinline__ void stage_rc(int b, int& R, int& C) { const int st = b / 1024, sb = b % 1024, swz = sb ^ (((sb >> 9) & 1) << 5); R = (st >> 1) * 16 + swz / 64; C = (st & 1) * 32 + (swz % 64) / 2; }
__device__ __forceinline__ int perm32(int rho) { const int n = rho >> 4, i = rho & 15; return 8 * (i >> 2) + 4 * n + (i & 3); }
struct Unit { int pm, pn; };
struct Gemm { const bf16_t* A; const bf16_t* Bt; int M, N, K, lda, ldb, ksplit; long asplit; };
struct StaticOrder {
    int nM, nN, nwg, G, c;
    __device__ void init(int M, int N, int G_, int c_) { nM = M / BM; nN = N / BM; nwg = nM * nN; G = G_; c = c_; }
    __device__ bool next(int i, Unit& u) const {
        const long L = (long)i * G + c; if (L >= nwg) return false;
        int wgid = (int)L; { const int q = nwg / NXCD, r = nwg % NXCD, xcd = wgid % NXCD, off = wgid / NXCD; wgid = (xcd < r ? xcd * (q + 1) : r * (q + 1) + (xcd - r) * q) + off; }
        const int nig = WGM * nN, gid = wgid / nig, fm = gid * WGM, gsz = (nM - fm) < WGM ? (nM - fm) : WGM;
        u.pm = fm + ((wgid % nig) % gsz); u.pn = (wgid % nig) / gsz; return true;
    }
};
__device__ __forceinline__ unsigned cvt_pk_bf16(float lo, float hi) { unsigned r; asm volatile("v_cvt_pk_bf16_f32 %0, %1, %2" : "=v"(r) : "v"(lo), "v"(hi)); return r; }

template <class Epi, class Sched>
__device__ __forceinline__ void gemm_phase(LAS unsigned char* lds, const Gemm g, const Sched& S, const Epi& E) {
    const int tid = threadIdx.x, wid = __builtin_amdgcn_readfirstlane(tid >> 6), lane = tid & 63, wr = wid >> 2, wc = wid & 3, fr = lane & 15, fq = lane >> 4;
    const int K = g.K, nt = K / BK;
    unsigned voffA[2], voffB[2];
#pragma unroll
    for (int i = 0; i < 2; ++i) { int R, C; stage_rc(tid * 16 + i * 8192, R, C); const int Rb = (R & ~31) + perm32(R & 31);
        voffA[i] = (unsigned)(R * g.lda + C) * 2u; voffB[i] = (unsigned)(Rb * g.ldb + C) * 2u; }
    const size_t kstep = (size_t)(BK * 2);
    const size_t hstepA = (size_t)HALF * g.lda * 2, hstepB = (size_t)HALF * g.ldb * 2;
    const size_t tstepA = 2 * hstepA, tstepB = 2 * hstepB;
    const unsigned ldsw = (unsigned)wid * 1024u;
    const int aoff = lds_byte(wr * 64 + fr, fq * 8), boff = lds_byte(wc * 32 + fr, fq * 8);
    const int ksplit = g.ksplit; const long asplit = g.asplit;
#define PG8_AP(base, t) ((base) + (size_t)(t) * kstep + (((t) >= ksplit) ? asplit : 0l))
#define PG8_SA(b, h) (((b) * 2 + (h)) * HTB)
#define PG8_SB(b, h) ((4 + (b) * 2 + (h)) * HTB)
#define PG8_STAGE(bufoff, gbase, voff) do { _Pragma("unroll") for (int _i = 0; _i < 2; ++_i) \
        __builtin_amdgcn_global_load_lds((const unsigned*)((const char*)(gbase) + (voff)[_i]), (LAS unsigned*)(lds + (bufoff) + ldsw + _i * 8192), 16, 0, 0); } while (0)
#define PG8_LDA(dst, b, h) do { _Pragma("unroll") for (int m = 0; m < 4; ++m) _Pragma("unroll") for (int k = 0; k < 2; ++k) dst[m][k] = *(const LAS bf16x8*)(lds + PG8_SA(b, h) + aoff + m * 2048 + k * 1024); } while (0)
#define PG8_LDB(dst, b, h) do { _Pragma("unroll") for (int n = 0; n < 2; ++n) _Pragma("unroll") for (int k = 0; k < 2; ++k) dst[n][k] = *(const LAS bf16x8*)(lds + PG8_SB(b, h) + boff + n * 2048 + k * 1024); } while (0)
#define PG8_MMA(ai, bj, At, Bt) do { __builtin_amdgcn_s_setprio(1); _Pragma("unroll") for (int m = 0; m < 4; ++m) _Pragma("unroll") for (int n = 0; n < 2; ++n) _Pragma("unroll") for (int k = 0; k < 2; ++k) \
        acc[ai][bj][m][n] = __builtin_amdgcn_mfma_f32_16x16x32_bf16(Bt[n][k], At[m][k], acc[ai][bj][m][n], 0, 0, 0); __builtin_amdgcn_s_setprio(0); } while (0)
#define PG8_WAIT_V(n) asm volatile("s_waitcnt vmcnt(" #n ")" ::: "memory")
#define PG8_WAIT_L(n) asm volatile("s_waitcnt lgkmcnt(" #n ")" ::: "memory")
#define PG8_BAR __builtin_amdgcn_s_barrier()
#define PG8_SCHED __builtin_amdgcn_sched_barrier(0)
    Unit cur, nxt; int ui = 0;
    if (!S.next(0, cur)) return;
    f32x4 acc[2][2][4][2];
#pragma unroll
    for (int a = 0; a < 2; ++a)
#pragma unroll
        for (int b = 0; b < 2; ++b)
#pragma unroll
            for (int m = 0; m < 4; ++m)
#pragma unroll
                for (int n = 0; n < 2; ++n) acc[a][b][m][n] = (f32x4){0.f, 0.f, 0.f, 0.f};
    bf16x8 At[4][2], B0[2][2], B1[2][2];
    const char* cA = (const char*)g.A + (size_t)cur.pm * tstepA; const char* cB = (const char*)g.Bt + (size_t)cur.pn * tstepB;
    PG8_STAGE(PG8_SB(0, 0), cB, voffB); PG8_STAGE(PG8_SA(0, 0), cA, voffA); PG8_STAGE(PG8_SB(0, 1), cB + hstepB, voffB); PG8_STAGE(PG8_SA(0, 1), cA + hstepA, voffA);
    if (wr == 1) PG8_BAR;
    PG8_WAIT_V(4); PG8_BAR;
    PG8_STAGE(PG8_SB(1, 0), cB + kstep, voffB); PG8_STAGE(PG8_SA(1, 0), cA + kstep, voffA); PG8_STAGE(PG8_SB(1, 1), cB + hstepB + kstep, voffB);
    PG8_WAIT_V(6); PG8_BAR;
    for (;;) {
        const bool has_next = S.next(ui + 1, nxt);
        const char* nA = has_next ? (const char*)g.A + (size_t)nxt.pm * tstepA : cA; const char* nB = has_next ? (const char*)g.Bt + (size_t)nxt.pn * tstepB : cB;
        for (int t = 0; t < nt; t += 2) {
            const bool last = (t == nt - 2);
            const char* a1 = PG8_AP(cA, t + 1);
            const char* a2 = last ? nA : PG8_AP(cA, t + 2); const char* b2 = last ? nB : cB + (size_t)(t + 2) * kstep;
            const char* a3 = last ? nA + kstep : PG8_AP(cA, t + 3); const char* b3 = b2 + kstep;
            PG8_LDB(B0, 0, 0); PG8_SCHED; PG8_LDA(At, 0, 0); PG8_STAGE(PG8_SA(1, 1), a1 + hstepA, voffA);
            PG8_WAIT_L(8); PG8_BAR; PG8_WAIT_L(0); PG8_MMA(0, 0, At, B0); PG8_BAR; PG8_SCHED;
            PG8_LDB(B1, 0, 1); PG8_STAGE(PG8_SB(0, 0), b2, voffB);
            PG8_BAR; PG8_WAIT_L(0); PG8_MMA(0, 1, At, B1); PG8_BAR;
            PG8_LDA(At, 0, 1); PG8_STAGE(PG8_SA(0, 0), a2, voffA);
            PG8_BAR; PG8_WAIT_L(0); PG8_MMA(1, 0, At, B0); PG8_BAR; PG8_SCHED;
            PG8_STAGE(PG8_SB(0, 1), b2 + hstepB, voffB);
            PG8_WAIT_V(6); PG8_BAR; PG8_MMA(1, 1, At, B1); PG8_BAR;
            PG8_LDB(B0, 1, 0); PG8_SCHED; PG8_LDA(At, 1, 0); PG8_STAGE(PG8_SA(0, 1), a2 + hstepA, voffA);
            PG8_WAIT_L(8); PG8_BAR; PG8_WAIT_L(0); PG8_MMA(0, 0, At, B0); PG8_BAR; PG8_SCHED;
            PG8_LDB(B1, 1, 1); PG8_STAGE(PG8_SB(1, 0), b3, voffB);
            PG8_BAR; PG8_WAIT_L(0); PG8_MMA(0, 1, At, B1); PG8_BAR;
            PG8_LDA(At, 1, 1); PG8_STAGE(PG8_SA(1, 0), a3, voffA);
            PG8_BAR; PG8_WAIT_L(0); PG8_MMA(1, 0, At, B0); PG8_BAR; PG8_SCHED;
            PG8_STAGE(PG8_SB(1, 1), b3 + hstepB, voffB);
            PG8_WAIT_V(6); PG8_BAR; PG8_MMA(1, 1, At, B1); PG8_BAR;
        }
        { int l2 = threadIdx.x & 63; asm volatile("" : "+v"(l2)); E(acc, cur, wr, wc, l2 & 15, l2 >> 4); }
        if (!has_next) break;
#pragma unroll
        for (int a = 0; a < 2; ++a)
#pragma unroll
            for (int b = 0; b < 2; ++b)
#pragma unroll
                for (int m = 0; m < 4; ++m)
#pragma unroll
                    for (int n = 0; n < 2; ++n) acc[a][b][m][n] = (f32x4){0.f, 0.f, 0.f, 0.f};
        cur = nxt; cA = nA; cB = nB; ++ui;
    }
    PG8_WAIT_V(0);
    if (wr == 0) PG8_BAR;
    PG8_BAR;
#undef PG8_AP
#undef PG8_SA
#undef PG8_SB
#undef PG8_STAGE
#undef PG8_LDA
#undef PG8_LDB
#undef PG8_MMA
#undef PG8_WAIT_V
#undef PG8_WAIT_L
#undef PG8_BAR
#undef PG8_SCHED
}

struct EpiBf16 {
    bf16_t* O; int ldc;
    __device__ __forceinline__ void operator()(const f32x4 (&acc)[2][2][4][2], const Unit& u, int wr, int wc, int fr, int fq) const {
        const int row0 = u.pm * BM + wr * 64 + fr, col0 = u.pn * BM + wc * 32 + 8 * fq;
#pragma unroll
        for (int ai = 0; ai < 2; ++ai)
#pragma unroll
            for (int m = 0; m < 4; ++m) { bf16_t* rowp = O + (size_t)(row0 + ai * HALF + m * 16) * ldc + col0;
#pragma unroll
                for (int bj = 0; bj < 2; ++bj) { const f32x4 v0 = acc[ai][bj][m][0], v1 = acc[ai][bj][m][1];
                    u32x4 w; w.x = cvt_pk_bf16(v0[0], v0[1]); w.y = cvt_pk_bf16(v0[2], v0[3]); w.z = cvt_pk_bf16(v1[0], v1[1]); w.w = cvt_pk_bf16(v1[2], v1[3]);
                    *(u32x4*)(rowp + bj * HALF) = w; } }
    }
};
struct EpiSwiglu {
    bf16_t* O; int ldc;
    __device__ __forceinline__ void operator()(const f32x4 (&acc)[2][2][4][2], const Unit& u, int wr, int wc, int fr, int fq) const {
        const int row0 = u.pm * BM + wr * 64 + fr, col0 = u.pn * HALF + wc * 32 + 8 * fq;
#pragma unroll
        for (int ai = 0; ai < 2; ++ai)
#pragma unroll
            for (int m = 0; m < 4; ++m) { bf16_t* rowp = O + (size_t)(row0 + ai * HALF + m * 16) * ldc + col0;
                float r[8];
#pragma unroll
                for (int n = 0; n < 2; ++n)
#pragma unroll
                    for (int j = 0; j < 4; ++j) { const float gt = acc[ai][0][m][n][j], up = acc[ai][1][m][n][j]; r[n * 4 + j] = silu_f(gt) * up; }
                u32x4 w; w.x = cvt_pk_bf16(r[0], r[1]); w.y = cvt_pk_bf16(r[2], r[3]); w.z = cvt_pk_bf16(r[4], r[5]); w.w = cvt_pk_bf16(r[6], r[7]);
                *(u32x4*)rowp = w; }
    }
};
struct EpiCT {
    bf16_t* CT;
    __device__ __forceinline__ void operator()(const f32x4 (&acc)[2][2][4][2], const Unit& u, int wr, int wc, int fr, int fq) const {
        const int r0 = u.pn * BM; int rb, L; row_info(r0, rb, L);
        const int tloc = (r0 - rb) + wc * 32 + 8 * fq;
        {
            bf16_t* base = CT + (size_t)rb * 2048 + tloc;
#pragma unroll
            for (int ai = 0; ai < 2; ++ai)
#pragma unroll
                for (int m = 0; m < 4; ++m) { const int ch = u.pm * BM + ai * HALF + wr * 64 + m * 16 + fr; bf16_t* rowp = base + (size_t)ch * L;
#pragma unroll
                    for (int bj = 0; bj < 2; ++bj) { const f32x4 v0 = acc[ai][bj][m][0], v1 = acc[ai][bj][m][1];
                        u32x4 w; w.x = cvt_pk_bf16(v0[0], v0[1]); w.y = cvt_pk_bf16(v0[2], v0[3]); w.z = cvt_pk_bf16(v1[0], v1[1]); w.w = cvt_pk_bf16(v1[2], v1[3]);
                        *(u32x4*)(rowp + bj * HALF) = w; } }
        }
    }
};
struct EpiQKG {
    bf16_t* Q; bf16_t* Kk; bf16_t* SG; const v2f* rot;
    __device__ __forceinline__ void operator()(const f32x4 (&acc)[2][2][4][2], const Unit& u, int wr, int wc, int fr, int fq) const {
        const int row0 = u.pm * BM + wr * 64 + fr; int rb, L; row_info(u.pm * BM, rb, L);
        if (u.pn < 4) {
            bf16_t* O = (u.pn < 2) ? Q : Kk; const float sc = (u.pn < 2) ? 1.0f : 0.08838834764831845f;
            const int head = 2 * (u.pn & 1) + (wc >> 1), dd0 = (wc & 1) * 32 + 8 * fq;
            f32x4 cb[4], s16[4], s128[4];
            { const v2f* rp = rot + (size_t)(row0 - rb) * 64 + dd0; const v2f* r16 = rot + (size_t)16 * 64 + dd0; const v2f* r128 = rot + (size_t)128 * 64 + dd0;
#pragma unroll
              for (int i = 0; i < 4; ++i) { cb[i] = *(const f32x4*)(rp + 2 * i); s16[i] = *(const f32x4*)(r16 + 2 * i); s128[i] = *(const f32x4*)(r128 + 2 * i); } }
#pragma unroll
            for (int ai = 0; ai < 2; ++ai) {
                f32x4 cur[4];
#pragma unroll
                for (int i = 0; i < 4; ++i) { cur[i] = cb[i];
                    if (ai == 1) { f32x4 t; t[0] = cb[i][0] * s128[i][0] - cb[i][1] * s128[i][1]; t[1] = cb[i][0] * s128[i][1] + cb[i][1] * s128[i][0];
                        t[2] = cb[i][2] * s128[i][2] - cb[i][3] * s128[i][3]; t[3] = cb[i][2] * s128[i][3] + cb[i][3] * s128[i][2]; cur[i] = t; } }
#pragma unroll
                for (int m = 0; m < 4; ++m) { const int row = row0 + ai * HALF + m * 16;
                    if (m > 0) {
#pragma unroll
                        for (int i = 0; i < 4; ++i) { f32x4 t; t[0] = cur[i][0] * s16[i][0] - cur[i][1] * s16[i][1]; t[1] = cur[i][0] * s16[i][1] + cur[i][1] * s16[i][0];
                            t[2] = cur[i][2] * s16[i][2] - cur[i][3] * s16[i][3]; t[3] = cur[i][2] * s16[i][3] + cur[i][3] * s16[i][2]; cur[i] = t; } }
                    float o1[8], o2[8];
#pragma unroll
                    for (int n = 0; n < 2; ++n)
#pragma unroll
                        for (int j = 0; j < 4; ++j) { const int k = n * 4 + j; const float c = cur[k >> 1][(k & 1) * 2], sn = cur[k >> 1][(k & 1) * 2 + 1];
                            const float x1 = acc[ai][0][m][n][j], x2 = acc[ai][1][m][n][j];
                            o1[k] = (x1 * c - x2 * sn) * sc; o2[k] = (x1 * sn + x2 * c) * sc; }
                    bf16_t* dst = O + (size_t)row * 512 + head * 128 + dd0;
                    u32x4 w; w.x = cvt_pk_bf16(o1[0], o1[1]); w.y = cvt_pk_bf16(o1[2], o1[3]); w.z = cvt_pk_bf16(o1[4], o1[5]); w.w = cvt_pk_bf16(o1[6], o1[7]);
                    *(u32x4*)dst = w;
                    w.x = cvt_pk_bf16(o2[0], o2[1]); w.y = cvt_pk_bf16(o2[2], o2[3]); w.z = cvt_pk_bf16(o2[4], o2[5]); w.w = cvt_pk_bf16(o2[6], o2[7]);
                    *(u32x4*)(dst + 64) = w; } }
        } else {
            const int col0 = (u.pn - 4) * BM + wc * 32 + 8 * fq;
#pragma unroll
            for (int ai = 0; ai < 2; ++ai)
#pragma unroll
                for (int m = 0; m < 4; ++m) { bf16_t* rowp = SG + (size_t)(row0 + ai * HALF + m * 16) * 512 + col0;
#pragma unroll
                    for (int bj = 0; bj < 2; ++bj) { const f32x4 v0 = acc[ai][bj][m][0], v1 = acc[ai][bj][m][1];
                        u32x4 w; w.x = cvt_pk_bf16(silu_f(v0[0]), silu_f(v0[1])); w.y = cvt_pk_bf16(silu_f(v0[2]), silu_f(v0[3]));
                        w.z = cvt_pk_bf16(silu_f(v1[0]), silu_f(v1[1])); w.w = cvt_pk_bf16(silu_f(v1[2]), silu_f(v1[3]));
                        *(u32x4*)(rowp + bj * HALF) = w; } }
        }
    }
};
}
#define FFT_HD __device__ __forceinline__

FFT_HD v2f cmul(v2f a, v2f b) {
    v2f t, r;
    asm("v_pk_mul_f32 %0, %1, %2 op_sel_hi:[0,1]" : "=v"(t) : "v"(a), "v"(b));
    asm("v_pk_fma_f32 %0, %1, %2, %3 op_sel:[1,1,0] op_sel_hi:[1,0,1] neg_lo:[1,0,0]" : "=v"(r) : "v"(a), "v"(b), "v"(t));
    return r;
}
FFT_HD constexpr int brev_c(int x, int bits) { int r = 0; for (int i = 0; i < bits; ++i) r |= ((x >> i) & 1) << (bits - 1 - i); return r; }
template <int R> struct Log2R { static constexpr int v = (R == 32) ? 5 : (R == 16) ? 4 : (R == 8) ? 3 : (R == 4) ? 2 : 1; };
FFT_HD constexpr float cos32c(int i) {
    switch (i & 15) {
        case 0: return 1.0f; case 1: return 0.98078528040323043f; case 2: return 0.92387953251128674f; case 3: return 0.83146961230254524f;
        case 4: return 0.70710678118654752f; case 5: return 0.55557023301960218f; case 6: return 0.38268343236508977f; case 7: return 0.19509032201612825f;
        case 8: return 0.0f; case 9: return -0.19509032201612825f; case 10: return -0.38268343236508977f; case 11: return -0.55557023301960218f;
        case 12: return -0.70710678118654752f; case 13: return -0.83146961230254524f; case 14: return -0.92387953251128674f; default: return -0.98078528040323043f;
    }
}
FFT_HD constexpr float sin32c(int i) {
    switch (i & 15) {
        case 0: return 0.0f; case 1: return 0.19509032201612825f; case 2: return 0.38268343236508977f; case 3: return 0.55557023301960218f;
        case 4: return 0.70710678118654752f; case 5: return 0.83146961230254524f; case 6: return 0.92387953251128674f; case 7: return 0.98078528040323043f;
        case 8: return 1.0f; case 9: return 0.98078528040323043f; case 10: return 0.92387953251128674f; case 11: return 0.83146961230254524f;
        case 12: return 0.70710678118654752f; case 13: return 0.55557023301960218f; case 14: return 0.38268343236508977f; default: return 0.19509032201612825f;
    }
}
template <int R, bool INV> FFT_HD void dftR(v2f (&v)[R]) {
#pragma unroll
    for (int half = R / 2; half >= 1; half >>= 1) {
#pragma unroll
        for (int i = 0; i < R; ++i) {
            if ((i & half) == 0) {
                const int j = i + half;
                const int p = (i & (half - 1)) * (16 / half);
                const v2f a = v[i], b = v[j];
                v[i] = a + b;
                const v2f d = a - b;
                if (p == 0) { v[j] = d; }
                else {
                    const float c = cos32c(p), s = sin32c(p);
                    v2f r;
                    if (INV) { r.x = d.x * c - d.y * s; r.y = d.x * s + d.y * c; }
                    else     { r.x = d.x * c + d.y * s; r.y = d.y * c - d.x * s; }
                    v[j] = r;
                }
            }
        }
    }
}
template <int R> FFT_HD void tw_brev(v2f (&v)[R], v2f w) {
    v2f wk = w;
#pragma unroll
    for (int k = 1; k < R; ++k) { const int i = brev_c(k, Log2R<R>::v); v[i] = cmul(v[i], wk); wk = cmul(wk, w); }
}
template <int R> FFT_HD void tw_nat(v2f (&v)[R], v2f w) {
    v2f wk = w;
#pragma unroll
    for (int k = 1; k < R; ++k) { v[k] = cmul(v[k], wk); wk = cmul(wk, w); }
}
FFT_HD int opaque_i(int x) {
#if defined(__HIP_DEVICE_COMPILE__)
    asm volatile("" : "+v"(x));
#endif
    return x;
}
FFT_HD v2f unit_root(float frac2  , bool conj) {
    float s, c;
    sincospif(frac2, &s, &c);
    v2f w; w.x = c; w.y = conj ? s : -s; return w;
}

template <int N1_, int N2_, int N3_, int NT_> struct FftCfg {
    static constexpr int N1 = N1_, N2 = N2_, N3 = N3_, NT = NT_, N = N1_ * N2_ * N3_, S1 = N2_ * N3_;
    static constexpr int RS0 = S1 + S1 / 16;
    static constexpr int RS = RS0 + (((RS0 * 2) % 64 == 0) ? 16 : 0);
    static constexpr int PHYS = N1_ * RS;
    static constexpr int P2 = (N1_ * N3_) / NT_;
    static constexpr int P3 = (N1_ * N2_) / NT_;
};

template <class C, class BUF> FFT_HD void pass1_fwd(v2f (&v)[32], int lt, BUF buf) {
    static_assert(C::N1 == 32 && C::S1 == C::NT, "cfg");
    dftR<32, false>(v);
    tw_brev<32>(v, unit_root(2.0f * (float)opaque_i(lt) / (float)C::N, false));
#pragma unroll
    for (int k = 0; k < 32; ++k) buf[lt + (lt >> 4) + k * C::RS] = v[brev_c(k, 5)];
}
template <class C, bool INV, class BUF> FFT_HD void pass2(int lt, BUF buf) {
#pragma unroll 1
    for (int q = 0; q < C::P2; ++q) {
        const int d = lt + q * C::NT, k1 = d / C::N3, n3 = d % C::N3, base = k1 * C::RS + n3;
        v2f v[C::N2];
#pragma unroll
        for (int j = 0; j < C::N2; ++j) v[j] = buf[base + j * 17];
        const v2f w = unit_root(2.0f * (float)opaque_i(n3) / (float)(C::N2 * C::N3), INV);
        if (!INV) { dftR<C::N2, false>(v); tw_brev<C::N2>(v, w); }
        else      { tw_nat<C::N2>(v, w); dftR<C::N2, true>(v); }
#pragma unroll
        for (int k = 0; k < C::N2; ++k) buf[base + k * 17] = v[brev_c(k, Log2R<C::N2>::v)];
    }
}
template <class C, class BUF> FFT_HD void pass3_filter(int lt, BUF buf, unsigned* ks, float bias) {
    static_assert(C::N3 == 16, "cfg");
#pragma unroll
    for (int q = 0; q < C::P3; ++q) {
        const int dd = lt + q * C::NT, base = (dd / C::N2) * C::RS + (dd % C::N2) * 17;
        v2f v[16];
#pragma unroll
        for (int j = 0; j < 16; ++j) v[j] = buf[base + j];
        dftR<16, false>(v);
#pragma unroll
        for (int k = 0; k < 16; ++k) { const v2f x = v[brev_c(k, 4)]; const __half2 hh = __floats2half2_rn(x.x + bias, x.y);
            ks[(q * 16 + k) * C::NT + lt] = __builtin_bit_cast(unsigned, hh); }
    }
}
template <class C, class BUF> FFT_HD void pass3_fused(int lt, BUF buf, const unsigned* ks) {
#pragma unroll
    for (int q = 0; q < C::P3; ++q) {
        const int dd = lt + q * C::NT, base = (dd / C::N2) * C::RS + (dd % C::N2) * 17;
        v2f v[16], u[16];
        unsigned kw[16];
#pragma unroll
        for (int k = 0; k < 16; ++k) kw[k] = ks[(q * 16 + k) * C::NT + lt];
#pragma unroll
        for (int j = 0; j < 16; ++j) v[j] = buf[base + j];
        dftR<16, false>(v);
#pragma unroll
        for (int k = 0; k < 16; ++k) { const float2 kf = __half22float2(__builtin_bit_cast(__half2, kw[k])); v2f kk; kk.x = kf.x; kk.y = kf.y; u[k] = cmul(v[brev_c(k, 4)], kk); }
        dftR<16, true>(u);
#pragma unroll
        for (int n = 0; n < 16; ++n) buf[base + n] = u[brev_c(n, 4)];
    }
}
template <class C, class BUF> FFT_HD void pass1_inv(v2f (&v)[32], int lt, BUF buf) {
#pragma unroll
    for (int k = 0; k < 32; ++k) v[k] = buf[lt + (lt >> 4) + k * C::RS];
    tw_nat<32>(v, unit_root(2.0f * (float)opaque_i(lt) / (float)C::N, true));
    dftR<32, true>(v);
}

__device__ __forceinline__ int perm_qk(int x) { const int head = x >> 7, d = x & 127; return (head >> 1) * 256 + (d >> 6) * 128 + (head & 1) * 64 + (d & 63); }

__device__ void transpose_tile(const float* __restrict__ src, int srcN, int k0, int n0, bf16_t* dst, int dstld, int job, LAS float* tile) {
    const int tid = threadIdx.x;
#pragma unroll
    for (int i = 0; i < 8; ++i) { const int kk = (tid >> 6) + i * 8, nn = tid & 63; tile[kk * 65 + nn] = src[(size_t)(k0 + kk) * srcN + n0 + nn]; }
    __syncthreads();
    const int nn = tid >> 3, kk8 = (tid & 7) * 8, n = n0 + nn;
    u32x4 w;
    w.x = pack_bf(tile[(kk8 + 0) * 65 + nn], tile[(kk8 + 1) * 65 + nn]); w.y = pack_bf(tile[(kk8 + 2) * 65 + nn], tile[(kk8 + 3) * 65 + nn]);
    w.z = pack_bf(tile[(kk8 + 4) * 65 + nn], tile[(kk8 + 5) * 65 + nn]); w.w = pack_bf(tile[(kk8 + 6) * 65 + nn], tile[(kk8 + 7) * 65 + nn]);
    int row = n, row2 = -1;
    if (job == 0) row = (n >> 7) * 256 + (n & 127);
    else if (job == 1) row = (n >> 7) * 256 + 128 + (n & 127);
    else if (job == 3) {
        if (n < 1536) row = n;
        else if (n < 2048) row = 2048 + perm_qk(n - 1536);
        else if (n < 2560) row = 2560 + perm_qk(n - 2048);
        else if (n < 3072) row = 1536 + (n - 2560);
        else row = 3072 + (n - 3072);
    }
    *(u32x4*)(dst + (size_t)row * dstld + k0 + kk8) = w;
    if (row2 >= 0) *(u32x4*)(dst + (size_t)row2 * dstld + k0 + kk8) = w;
    __syncthreads();
}

__device__ void phase0_transposes(const Params& p, LAS float* tile) {
    for (int t = blockIdx.x; t < 5376 * REP_TR; t += gridDim.x) {
        int r = t % 5376;
        if (r < 704) { transpose_tile(p.in[3], 2816, (r / 44) * 64, (r % 44) * 64, (bf16_t*)(p.ws + OFF_WUP1), 1024, 0, tile); continue; } r -= 704;
        if (r < 704) { transpose_tile(p.in[4], 2816, (r / 44) * 64, (r % 44) * 64, (bf16_t*)(p.ws + OFF_WUP1), 1024, 1, tile); continue; } r -= 704;
        if (r < 704) { transpose_tile(p.in[5], 1024, (r / 16) * 64, (r % 16) * 64, (bf16_t*)(p.ws + OFF_WDN1), 2816, 2, tile); continue; } r -= 704;
        if (r < 896) { transpose_tile(p.in[8], 3584, (r / 56) * 64, (r % 56) * 64, (bf16_t*)(p.ws + OFF_WIN), 1024, 3, tile); continue; } r -= 896;
        if (r < 256) { transpose_tile(p.in[22], 1024, (r / 16) * 64, (r % 16) * 64, (bf16_t*)(p.ws + OFF_WOUT), 1024, 2, tile); continue; } r -= 256;
        if (r < 704) { transpose_tile(p.in[25], 2816, (r / 44) * 64, (r % 44) * 64, (bf16_t*)(p.ws + OFF_WUP2), 1024, 0, tile); continue; } r -= 704;
        if (r < 704) { transpose_tile(p.in[26], 2816, (r / 44) * 64, (r % 44) * 64, (bf16_t*)(p.ws + OFF_WUP2), 1024, 1, tile); continue; } r -= 704;
        transpose_tile(p.in[27], 1024, (r / 16) * 64, (r % 16) * 64, (bf16_t*)(p.ws + OFF_WDN2), 2816, 2, tile);
    }
}

__device__ void phase0_rot(const Params& p) {
    v2f* rot = (v2f*)(p.ws + OFF_ROT);
    for (int i = blockIdx.x * 512 + threadIdx.x; i < 8192 * 64; i += gridDim.x * 512) {
        const int pos = i >> 6, f = i & 63;
        const float inv = 1.0f / powf(10000.0f, (float)(2 * f) / 128.0f);
        const float ang = (float)pos * inv;
        float s, c; sincosf(ang, &s, &c);
        v2f cs; cs.x = c; cs.y = s;
        rot[i] = cs;
    }
}

__device__ __forceinline__ const float* x_row(const Params& p, int r) { return r < T_P ? p.in[0] + (size_t)r * 1024 : p.in[1] + (size_t)(r - T_P) * 1024; }
__device__ __forceinline__ void load_bf_row(const char* base, int lane, float (&v)[16]) {
#pragma unroll
    for (int i = 0; i < 4; ++i) { const u32x2 w = *(const u32x2*)(base + (lane * 4 + 256 * i) * 2); v[4 * i] = bflo(w.x); v[4 * i + 1] = bfhi(w.x); v[4 * i + 2] = bflo(w.y); v[4 * i + 3] = bfhi(w.y); }
}
__device__ __forceinline__ void store_bf_row(char* base, int lane, const float (&v)[16]) {
#pragma unroll
    for (int i = 0; i < 4; ++i) { u32x2 w; w.x = pack_bf(v[4 * i], v[4 * i + 1]); w.y = pack_bf(v[4 * i + 2], v[4 * i + 3]); *(u32x2*)(base + (lane * 4 + 256 * i) * 2) = w; }
}
__device__ __forceinline__ void load_f_row(const float* base, int lane, float (&v)[16]) {
#pragma unroll
    for (int i = 0; i < 4; ++i) { const f32x4 w = *(const f32x4*)(base + lane * 4 + 256 * i); v[4 * i] = w[0]; v[4 * i + 1] = w[1]; v[4 * i + 2] = w[2]; v[4 * i + 3] = w[3]; }
}
__device__ __forceinline__ float row_rs(const float (&v)[16]) { float ss = 0.f;
#pragma unroll
    for (int i = 0; i < 16; ++i) ss += v[i] * v[i];
    ss = wave_sum(ss); return rsqrtf(ss * (1.0f / 1024.0f) + 1e-6f); }

__device__ void row_phase(const Params& p, int mode, const float* g0p, const float* g1p, int rep = 1) {
    const int lane = threadIdx.x & 63, gw = blockIdx.x * 8 + (threadIdx.x >> 6), nw = gridDim.x * 8;
    float g0[16], g1[16];
    load_f_row(g0p, lane, g0);
    if (g1p) load_f_row(g1p, lane, g1);
    for (int rr = gw; rr < T_ALL * rep; rr += nw) {
        const int r = rr % T_ALL;
        char* slot = (char*)p.out + (size_t)r * 4096;
        float x[16]; load_f_row(x_row(p, r), lane, x);
        if (mode == 0) {
            const float rs = row_rs(x); float h[16];
#pragma unroll
            for (int i = 0; i < 16; ++i) h[i] = x[i] * rs * g0[i];
            store_bf_row(slot + 2048, lane, h);
        } else {
            float f[16]; load_bf_row(slot + 2048, lane, f);
            const float rs = row_rs(f);
            float d[16];
            if (mode >= 2) load_bf_row(slot, lane, d);
            const float sc = (mode == 2) ? 1.0f : 0.5f;
            if (mode == 3) {
#pragma unroll
                for (int i = 0; i < 4; ++i) { f32x4 w;
#pragma unroll
                    for (int j = 0; j < 4; ++j) w[j] = x[4 * i + j] + d[4 * i + j] + sc * f[4 * i + j] * rs * g0[4 * i + j];
                    *(f32x4*)(slot + (lane * 4 + 256 * i) * 4) = w; }
            } else {
                float xn[16];
#pragma unroll
                for (int i = 0; i < 16; ++i) { float b = sc * f[i] * rs * g0[i]; if (mode == 2) b += d[i]; d[i] = b; xn[i] = x[i] + b; }
                store_bf_row(slot, lane, d);
                const float rs2 = row_rs(xn); float h[16];
#pragma unroll
                for (int i = 0; i < 16; ++i) h[i] = xn[i] * rs2 * g1[i];
                store_bf_row(slot + 2048, lane, h);
            }
        }
    }
}

__device__ void filter_unit(const Params& p, int unit, LAS unsigned char* lds) {
    const int Lsel = unit >= 64 ? 1 : 0, L = Lsel ? 8192 : 4096, t0 = (Lsel ? unit - 64 : unit) * 64;
    LAS float* zs = (LAS float*)lds;
    LAS float* hA = zs + 64 * 33;
    LAS float* hB = hA + 64 * 65;
    LAS float* Ws = hB + 64 * 65;
    LAS bf16_t* h3b = (LAS bf16_t*)(Ws + 64 * 64);
    LAS bf16_t* w4t = h3b + 64 * 72;
    const int tid = threadIdx.x;
    const float* W1 = p.in[11]; const float* B1 = p.in[12]; const float* W2 = p.in[13]; const float* B2 = p.in[14];
    const float* W3 = p.in[15]; const float* B3 = p.in[16]; const float* W4 = p.in[17]; const float* FR = p.in[18];
    __syncthreads();
    if (tid < 64) {
        const int t = t0 + tid;
        zs[tid * 33] = (float)t / (float)(L - 1);
        const float w = 6.283185307179586f * (float)t / (float)L;
#pragma unroll 1
        for (int b = 0; b < 16; ++b) { const float fb = 1e-4f + (float)b * ((15.0f - 1e-4f) / 15.0f); const float a = fb * w; float s, c; sincosf(a, &s, &c);
            zs[tid * 33 + 1 + b] = c; zs[tid * 33 + 17 + b] = -s; }
    }
    for (int i = tid; i < 33 * 64; i += 512) Ws[i] = W1[i];
    __syncthreads();
    const int t = tid & 63, kg = tid >> 6;
#pragma unroll 1
    for (int layer = 0; layer < 3; ++layer) {
        const LAS float* hin = layer == 0 ? zs : (layer == 1 ? hA : hB);
        LAS float* hout = layer == 1 ? hB : hA;
        const int istr = layer == 0 ? 33 : 65, nin = layer == 0 ? 33 : 64;
        const float* Bp = layer == 0 ? B1 : (layer == 1 ? B2 : B3);
        float a[8];
#pragma unroll
        for (int i = 0; i < 8; ++i) a[i] = Bp[kg * 8 + i];
#pragma unroll 4
        for (int j = 0; j < nin; ++j) { const float hv = hin[t * istr + j];
            const f32x4 w0 = *(const LAS f32x4*)(Ws + j * 64 + kg * 8), w1 = *(const LAS f32x4*)(Ws + j * 64 + kg * 8 + 4);
            a[0] += hv * w0[0]; a[1] += hv * w0[1]; a[2] += hv * w0[2]; a[3] += hv * w0[3]; a[4] += hv * w1[0]; a[5] += hv * w1[1]; a[6] += hv * w1[2]; a[7] += hv * w1[3]; }
        __syncthreads();
        const float* Wn = layer == 0 ? W2 : W3;
        if (layer < 2) for (int i = tid; i < 64 * 64; i += 512) Ws[i] = Wn[i];
#pragma unroll
        for (int i = 0; i < 8; ++i) { const float hv = sinf(FR[kg * 8 + i] * a[i]); if (layer < 2) hout[t * 65 + kg * 8 + i] = hv; else h3b[t * 72 + kg * 8 + i] = f2bf(hv); }
        __syncthreads();
    }
    const int wid = tid >> 6, lane = tid & 63, lr = lane & 15, lq = lane >> 4;
    bf16x8 afr[4][2];
#pragma unroll
    for (int mt = 0; mt < 4; ++mt)
#pragma unroll
        for (int ks = 0; ks < 2; ++ks) afr[mt][ks] = *(const LAS bf16x8*)(h3b + (16 * mt + lr) * 72 + 32 * ks + lq * 8);
    __half* hraw = (__half*)(p.ws + OFF_HRAW) + (Lsel ? (size_t)2048 * 4096 : (size_t)0);
#pragma unroll 1
    for (int quarter = 0; quarter < 4; ++quarter) {
#pragma unroll 4
        for (int i = 0; i < 64; ++i) { const int k = i, col = tid;
            w4t[col * 68 + k] = f2bf(W4[(size_t)k * 2048 + quarter * 512 + col]); }
        __syncthreads();
        f32x4 acc[4][4];
#pragma unroll
        for (int mt = 0; mt < 4; ++mt)
#pragma unroll
            for (int nt = 0; nt < 4; ++nt) acc[mt][nt] = (f32x4){0.f, 0.f, 0.f, 0.f};
#pragma unroll
        for (int nt = 0; nt < 4; ++nt)
#pragma unroll
            for (int ks = 0; ks < 2; ++ks) { const LAS bf16_t* bp = w4t + (64 * wid + 16 * nt + lr) * 68 + 32 * ks + lq * 8;
                const u32x2 b0 = *(const LAS u32x2*)bp, b1 = *(const LAS u32x2*)(bp + 4);
                u32x4 bw; bw.x = b0.x; bw.y = b0.y; bw.z = b1.x; bw.w = b1.y;
                const bf16x8 bfr = __builtin_bit_cast(bf16x8, bw);
#pragma unroll
                for (int mt = 0; mt < 4; ++mt) acc[mt][nt] = __builtin_amdgcn_mfma_f32_16x16x32_bf16(afr[mt][ks], bfr, acc[mt][nt], 0, 0, 0); }
#pragma unroll
        for (int nt = 0; nt < 4; ++nt) { const int col = quarter * 512 + 64 * wid + 16 * nt + lr, c = col & 511;
            const float ad = 3.0701134573253944f + (float)c * ((15.350567286626972f - 3.0701134573253944f) / 511.0f);
#pragma unroll
            for (int mt = 0; mt < 4; ++mt) { const int tt = t0 + 16 * mt + lq * 4;
                __half2 h01 = __floats2half2_rn(acc[mt][nt][0] * expf(-((float)(tt + 0) / (float)(L - 1)) * ad), acc[mt][nt][1] * expf(-((float)(tt + 1) / (float)(L - 1)) * ad));
                __half2 h23 = __floats2half2_rn(acc[mt][nt][2] * expf(-((float)(tt + 2) / (float)(L - 1)) * ad), acc[mt][nt][3] * expf(-((float)(tt + 3) / (float)(L - 1)) * ad));
                u32x2 w; w.x = __builtin_bit_cast(unsigned, h01); w.y = __builtin_bit_cast(unsigned, h23);
                *(u32x2*)(hraw + (size_t)col * L + tt) = w; } }
        __syncthreads();
    }
}
__device__ __forceinline__ float ldbf(const bf16_t* p) { return bf2f(*p); }
template <int NT, int L>
__device__ __forceinline__ void stage_conv_row(const bf16_t* row, int lt, float w0, float w1, float w2, float b, LAS unsigned short* stage) {
#pragma unroll
    for (int i = 0; i < L / 8 / NT; ++i) {
        const int tb = (lt + i * NT) * 8;
        const u32x4 w = *(const u32x4*)(row + tb);
        const unsigned short lo = row[tb > 0 ? tb - 1 : 0], hi = row[tb + 8 < L ? tb + 8 : L - 1];
        float u[10];
        u[0] = tb > 0 ? bf2f(lo) : 0.f; u[9] = tb + 8 < L ? bf2f(hi) : 0.f;
        u[1] = bflo(w.x); u[2] = bfhi(w.x); u[3] = bflo(w.y); u[4] = bfhi(w.y); u[5] = bflo(w.z); u[6] = bfhi(w.z); u[7] = bflo(w.w); u[8] = bfhi(w.w);
        float r[8];
#pragma unroll
        for (int k = 0; k < 8; ++k) r[k] = u[k] * w0 + u[k + 1] * w1 + u[k + 2] * w2 + b;
        u32x4 o;
        o.x = __builtin_bit_cast(unsigned, __floats2half2_rn(r[0], r[1])); o.y = __builtin_bit_cast(unsigned, __floats2half2_rn(r[2], r[3]));
        o.z = __builtin_bit_cast(unsigned, __floats2half2_rn(r[4], r[5])); o.w = __builtin_bit_cast(unsigned, __floats2half2_rn(r[6], r[7]));
        *(LAS u32x4*)(stage + tb) = o;
    }
}

template <class C>
__device__ void hyena_channel(const Params& p, LAS v2f* buf, LAS float* red, LAS unsigned short* stage, unsigned* ks, unsigned* zs, int lt_in, int Lsel, int c, bool do_store = true) {
    constexpr int N = C::N, L = N / 2, S1 = C::S1, NT = C::NT, NW = NT / 64;
    const bf16_t* CT = (const bf16_t*)(p.ws + OFF_CT);
    const float* SW = p.in[9]; const float* SB = p.in[10];
    const __half* hraw = (const __half*)(p.ws + OFF_HRAW) + (Lsel ? (size_t)2048 * 4096 : (size_t)0);
    bf16_t* ctw = (bf16_t*)(p.ws + OFF_CT);
#pragma unroll 1
    for (int o = 0; o < 2; ++o) {
#pragma unroll 1
        for (int st = 0; st < 3; ++st) {
            const int bb0 = Lsel * 4 + (st == 2 ? 2 : 0);
            const int rb0 = row_base(bb0), rb1 = row_base(bb0 + 1);
            const bf16_t* ct0 = CT + (size_t)rb0 * 2048; const bf16_t* ct1 = CT + (size_t)rb1 * 2048;
            unsigned* zp = zs + (st == 2 ? 16 * NT : 0);
            {
                const int lt = opaque_i(lt_in), lane = lt & 63, lw = lt >> 6;
                v2f v[32];
                if (st == 0) {
                    const __half* hf = hraw + (size_t)(o * 1024 + c) * L; const __half* hb = hf + (size_t)512 * L;
                    float sf = 0.f, sb = 0.f;
                    __half hr[32];
#pragma unroll
                    for (int j = 0; j < 16; ++j) hr[j] = hf[lt + j * S1];
#pragma unroll
                    for (int j = 16; j < 32; ++j) { const int idx = lt + j * S1; hr[j] = hb[N - idx == L ? 0 : N - idx]; }
                    __builtin_amdgcn_sched_barrier(0);
#pragma unroll
                    for (int j = 0; j < 16; ++j) { const float x = __half2float(hr[j]); v[j].x = x; v[j].y = 0.f; sf += fabsf(x); }
#pragma unroll
                    for (int j = 16; j < 32; ++j) { const int idx = lt + j * S1; const float x = __half2float(hr[j]); sb += fabsf(x);
                        v[j].x = (idx == L) ? 0.f : x; v[j].y = 0.f; }
                    sf = wave_sum(sf); sb = wave_sum(sb);
                    if (lane == 0) { red[lw * 2] = sf; red[lw * 2 + 1] = sb; }
                    __syncthreads();
                    float tf = 0.f, tb = 0.f;
#pragma unroll
                    for (int w = 0; w < NW; ++w) { tf += red[w * 2]; tb += red[w * 2 + 1]; }
                    const float isf = 1.0f / tf, isb = 1.0f / tb;
#pragma unroll
                    for (int j = 0; j < 16; ++j) v[j].x *= isf;
#pragma unroll
                    for (int j = 16; j < 32; ++j) v[j].x *= isb;
                } else {
                    if (o == 0) {
                        const float w0 = SW[c], w1 = SW[1536 + c], w2 = SW[3072 + c], b = SB[c];
                        stage_conv_row<NT, L>(ct0 + (size_t)c * L, lt, w0, w1, w2, b, stage);
                        __syncthreads();
#pragma unroll
                        for (int j = 0; j < 16; ++j) v[j].x = __half2float(__ushort_as_half(stage[lt + j * S1]));
                        __syncthreads();
                        stage_conv_row<NT, L>(ct1 + (size_t)c * L, lt, w0, w1, w2, b, stage);
                        __syncthreads();
#pragma unroll
                        for (int j = 0; j < 16; ++j) v[j].y = __half2float(__ushort_as_half(stage[lt + j * S1]));
                    } else {
#pragma unroll
                        for (int j = 0; j < 16; ++j) { const float2 zf = __half22float2(__builtin_bit_cast(__half2, zp[j * NT + lt])); v[j].x = zf.x; v[j].y = zf.y; }
                    }
#pragma unroll
                    for (int j = 16; j < 32; ++j) { v[j].x = 0.f; v[j].y = 0.f; }
                }
                pass1_fwd<C>(v, lt, buf);
            }
            __syncthreads();
            pass2<C, false>(opaque_i(lt_in), buf);
            __syncthreads();
            if (st == 0) { pass3_filter<C>(opaque_i(lt_in), buf, ks, p.in[19][o * 512 + c]); __syncthreads(); continue; }
            pass3_fused<C>(opaque_i(lt_in), buf, ks);
            __syncthreads();
            pass2<C, true>(opaque_i(lt_in), buf);
            __syncthreads();
            {
                const int lt = opaque_i(lt_in);
                const int ch = (o == 0 ? 512 : 1024) + c;
                const float w0 = SW[ch], w1 = SW[1536 + ch], w2 = SW[3072 + ch], b = SB[ch];
                v2f v[32];
                pass1_inv<C>(v, lt, buf);
                float yx[16], yy[16];
#pragma unroll
                for (int n1 = 0; n1 < 16; ++n1) { const v2f y = v[brev_c(n1, 5)] * (1.0f / (float)N); yx[n1] = y.x; yy[n1] = y.y; }
                stage_conv_row<NT, L>(ct0 + (size_t)ch * L, lt, w0, w1, w2, b, stage);
                __syncthreads();
#pragma unroll
                for (int n1 = 0; n1 < 16; ++n1) yx[n1] *= __half2float(__ushort_as_half(stage[lt + n1 * S1]));
                __syncthreads();
                stage_conv_row<NT, L>(ct1 + (size_t)ch * L, lt, w0, w1, w2, b, stage);
                __syncthreads();
#pragma unroll
                for (int n1 = 0; n1 < 16; ++n1) yy[n1] *= __half2float(__ushort_as_half(stage[lt + n1 * S1]));
#pragma unroll
                for (int n1 = 0; n1 < 16; ++n1) { const int t = lt + n1 * S1;
                    if (o == 0) { zp[n1 * NT + lt] = __builtin_bit_cast(unsigned, __floats2half2_rn(yx[n1], yy[n1])); }
                    else if (do_store) { ctw[(size_t)rb0 * 2048 + (size_t)c * L + t] = f2bf(yx[n1]); ctw[(size_t)rb1 * 2048 + (size_t)c * L + t] = f2bf(yy[n1]); } }
            }
            __syncthreads();
        }
    }
}

__device__ __forceinline__ char* sbuf_addr(const Params& p, int unit, int e, int dp) { return (char*)p.out + ((size_t)unit * 32 + (e >> 2)) * 4096 + 2048 + (e & 3) * 512 + dp * 2; }

__device__ __forceinline__ void rs_load(const Params& p, int unit, int tid, u32x4 (&rk)[4], u32x4 (&rv)[4]) {
    const int h = unit & 3, gc = unit >> 2, r0 = gc * 128; int rb, L; row_info(r0, rb, L); const int t0 = r0 - rb;
    const bf16_t* Kk = (const bf16_t*)(p.ws + OFF_K) + (size_t)r0 * 512 + h * 128;
    const bf16_t* vT = (const bf16_t*)(p.ws + OFF_CT) + (size_t)rb * 2048 + (size_t)(1536 + h * 128) * L + t0;
#pragma unroll
    for (int i = 0; i < 4; ++i) { const int q = tid + i * 512, row = q >> 4, c16 = q & 15, jr = q & 127, dc = q >> 7;
        rk[i] = *(const u32x4*)(Kk + (size_t)jr * 512 + dc * 8); rv[i] = *(const u32x4*)(vT + (size_t)row * L + c16 * 8); }
}
__device__ void ret_state_phase(const Params& p, LAS unsigned char* lds, int total) {
    int u = blockIdx.x;
    if (u >= total) return;
    LAS unsigned char* lK = lds; LAS unsigned char* lV = lds + 34816;
    u32x4 rk[4], rv[4];
    rs_load(p, u % 1536, opaque_i(threadIdx.x), rk, rv);
#pragma unroll 1
    for (;;) {
        const int unit = u % 1536;
        const int tid = opaque_i(threadIdx.x), wid = tid >> 6, lane = tid & 63, lr = lane & 15, lq = lane >> 4;
#pragma unroll
        for (int i = 0; i < 4; ++i) { const int q = tid + i * 512, row = q >> 4, c16 = q & 15, jr = q & 127, dc = q >> 7;
            LAS unsigned short* kt = (LAS unsigned short*)(lK + (dc * 8) * 272 + jr * 2);
            kt[0 * 136] = (unsigned short)(rk[i].x & 0xffffu); kt[1 * 136] = (unsigned short)(rk[i].x >> 16);
            kt[2 * 136] = (unsigned short)(rk[i].y & 0xffffu); kt[3 * 136] = (unsigned short)(rk[i].y >> 16);
            kt[4 * 136] = (unsigned short)(rk[i].z & 0xffffu); kt[5 * 136] = (unsigned short)(rk[i].z >> 16);
            kt[6 * 136] = (unsigned short)(rk[i].w & 0xffffu); kt[7 * 136] = (unsigned short)(rk[i].w >> 16);
            *(LAS u32x4*)(lV + row * 272 + c16 * 16) = rv[i]; }
        __syncthreads();
        const int un = u + gridDim.x; const bool has = un < total;
        if (has) rs_load(p, un % 1536, tid, rk, rv);
        const int h = unit & 3;
        const bool bwd = wid >= 4;
        const float lg = bwd ? p.in[21][h] : p.in[20][h];
        f32x4 acc[2][8];
#pragma unroll
        for (int a = 0; a < 2; ++a)
#pragma unroll
            for (int b = 0; b < 8; ++b) acc[a][b] = (f32x4){0.f, 0.f, 0.f, 0.f};
#pragma unroll
        for (int ks = 0; ks < 4; ++ks) {
            const int j0 = 32 * ks + lq * 8;
            float wk[8];
#pragma unroll
            for (int i = 0; i < 8; ++i) { const int j = j0 + i; wk[i] = __expf(lg * (float)(bwd ? j : 127 - j)); }
            bf16x8 a[2];
#pragma unroll
            for (int mt = 0; mt < 2; ++mt) { const int d = (32 * wid + 16 * mt + lr) & 127;
                const u32x4 raw = *(const LAS u32x4*)(lK + d * 272 + j0 * 2);
                u32x4 w;
                w.x = pack_bf(bflo(raw.x) * wk[0], bfhi(raw.x) * wk[1]); w.y = pack_bf(bflo(raw.y) * wk[2], bfhi(raw.y) * wk[3]);
                w.z = pack_bf(bflo(raw.z) * wk[4], bfhi(raw.z) * wk[5]); w.w = pack_bf(bflo(raw.w) * wk[6], bfhi(raw.w) * wk[7]);
                a[mt] = __builtin_bit_cast(bf16x8, w); }
#pragma unroll
            for (int nt = 0; nt < 8; ++nt) { const int e = 16 * nt + lr;
                const bf16x8 b = *(const LAS bf16x8*)(lV + e * 272 + j0 * 2);
#pragma unroll
                for (int mt = 0; mt < 2; ++mt) acc[mt][nt] = __builtin_amdgcn_mfma_f32_16x16x32_bf16(a[mt], b, acc[mt][nt], 0, 0, 0); }
            __builtin_amdgcn_sched_barrier(0);
        }
#pragma unroll
        for (int mt = 0; mt < 2; ++mt)
#pragma unroll
            for (int nt = 0; nt < 8; ++nt) { const int dp = 32 * wid + 16 * mt + lq * 4, e = 16 * nt + lr;
                u32x2 w; w.x = pack_bf(acc[mt][nt][0], acc[mt][nt][1]); w.y = pack_bf(acc[mt][nt][2], acc[mt][nt][3]);
                *(u32x2*)sbuf_addr(p, unit, e, dp) = w; }
        __syncthreads();
        if (!has) break;
        u = un;
    }
}

__device__ void ret_scan(const Params& p) {
#pragma unroll 1
    for (int gid = blockIdx.x * 512 + threadIdx.x; gid < 131072; gid += gridDim.x * 512) {
    const int dg = gid & 31, e = (gid >> 5) & 127, h = (gid >> 12) & 3, bb = gid >> 14;
    const bool bwd = dg >= 16;
    const float gC = __expf(128.0f * (bwd ? p.in[21][h] : p.in[20][h]));
    const int nc = bb < 4 ? 32 : 64, gc0 = row_base(bb) / 128;
    float run[8];
#pragma unroll
    for (int i = 0; i < 8; ++i) run[i] = 0.f;
#pragma unroll 1
    for (int it = 0; it < nc; it += 8) {
        u32x4 s[8]; char* ad[8];
#pragma unroll
        for (int q = 0; q < 8; ++q) { const int n = bwd ? (nc - 1 - it - q) : (it + q); ad[q] = sbuf_addr(p, (gc0 + n) * 4 + h, e, dg * 8); s[q] = *(const u32x4*)ad[q]; }
#pragma unroll
        for (int q = 0; q < 8; ++q) {
            u32x4 w; w.x = pack_bf(run[0], run[1]); w.y = pack_bf(run[2], run[3]); w.z = pack_bf(run[4], run[5]); w.w = pack_bf(run[6], run[7]);
            *(u32x4*)ad[q] = w;
            run[0] = gC * run[0] + bflo(s[q].x); run[1] = gC * run[1] + bfhi(s[q].x); run[2] = gC * run[2] + bflo(s[q].y); run[3] = gC * run[3] + bfhi(s[q].y);
            run[4] = gC * run[4] + bflo(s[q].z); run[5] = gC * run[5] + bfhi(s[q].z); run[6] = gC * run[6] + bflo(s[q].w); run[7] = gC * run[7] + bfhi(s[q].w);
        }
    }
    }
}

__device__ void ret_out_unit(const Params& p, int unit, LAS unsigned char* lds, bool do_store = true) {
    const int h = unit & 3, gc = unit >> 2, r0 = gc * 128; int rb, L; row_info(r0, rb, L); const int t0 = r0 - rb;
    bf16_t* Q = (bf16_t*)(p.ws + OFF_Q) + (size_t)r0 * 512 + h * 128;
    const bf16_t* Kk = (const bf16_t*)(p.ws + OFF_K) + (size_t)r0 * 512 + h * 128;
    const bf16_t* SG = (const bf16_t*)(p.ws + OFF_SG) + (size_t)r0 * 512 + h * 128;
    const bf16_t* vT = (const bf16_t*)(p.ws + OFF_CT) + (size_t)rb * 2048 + (size_t)(1536 + h * 128) * L + t0;
    const int tid = opaque_i(threadIdx.x), wid = tid >> 6, lane = tid & 63, lr = lane & 15, lq = lane >> 4;
    const float lgf = p.in[20][h], lgb = p.in[21][h];
    LAS unsigned char* lK = lds;
    LAS unsigned char* lV = lds + 34816;
    LAS unsigned char* lR = lds + 69632;
    bf16x8 qa[4];
    {
        u32x4 rr[8];
#pragma unroll
        for (int i = 0; i < 8; ++i) { const int q = tid + i * 512, row = q >> 5, c16 = q & 31; rr[i] = *(const u32x4*)sbuf_addr(p, unit, row, c16 * 8); }
#pragma unroll
        for (int i = 0; i < 8; ++i) { const int q = tid + i * 512, row = q >> 5, c16 = q & 31; *(LAS u32x4*)(lR + row * 528 + c16 * 16) = rr[i]; }
    }
    {
        u32x4 rk[4], rv[4];
#pragma unroll
        for (int i = 0; i < 4; ++i) { const int q = tid + i * 512, row = q >> 4, c16 = q & 15;
            rk[i] = *(const u32x4*)(Kk + (size_t)row * 512 + c16 * 8); rv[i] = *(const u32x4*)(vT + (size_t)row * L + c16 * 8); }
#pragma unroll
        for (int ks = 0; ks < 4; ++ks) qa[ks] = *(const bf16x8*)(Q + (size_t)(16 * wid + lr) * 512 + 32 * ks + lq * 8);
#pragma unroll
        for (int i = 0; i < 4; ++i) { const int q = tid + i * 512, row = q >> 4, c16 = q & 15;
            *(LAS u32x4*)(lK + row * 272 + c16 * 16) = rk[i]; *(LAS u32x4*)(lV + row * 272 + c16 * 16) = rv[i]; }
    }
    __syncthreads();
    f32x4 s[8];
#pragma unroll
    for (int nt = 0; nt < 8; ++nt) { s[nt] = (f32x4){0.f, 0.f, 0.f, 0.f};
#pragma unroll
        for (int ks = 0; ks < 4; ++ks) { const bf16x8 b = *(const LAS bf16x8*)(lK + (16 * nt + lr) * 272 + (32 * ks + lq * 8) * 2);
            s[nt] = __builtin_amdgcn_mfma_f32_16x16x32_bf16(qa[ks], b, s[nt], 0, 0, 0); }
        __builtin_amdgcn_sched_barrier(0); }
    __syncthreads();
    LAS bf16_t* Pw = (LAS bf16_t*)lK + wid * (16 * 136);
#pragma unroll
    for (int nt = 0; nt < 8; ++nt)
#pragma unroll
        for (int r = 0; r < 4; ++r) { const int i = 16 * wid + lq * 4 + r, j = 16 * nt + lr, diff = i - j;
            const float D = diff >= 0 ? __expf(lgf * (float)diff) : __expf(lgb * (float)(-diff));
            Pw[(lq * 4 + r) * 136 + j] = f2bf(s[nt][r] * D); }
    __syncthreads();
    bf16x8 pa[4];
#pragma unroll
    for (int ks = 0; ks < 4; ++ks) pa[ks] = *(const LAS bf16x8*)(Pw + lr * 136 + 32 * ks + lq * 8);
    f32x4 o1[8], of[8], ob[8];
#pragma unroll
    for (int nt = 0; nt < 8; ++nt) { const int e = 16 * nt + lr;
        o1[nt] = (f32x4){0.f, 0.f, 0.f, 0.f}; of[nt] = o1[nt]; ob[nt] = o1[nt];
#pragma unroll
        for (int ks = 0; ks < 4; ++ks) {
            const bf16x8 bv = *(const LAS bf16x8*)(lV + e * 272 + (32 * ks + lq * 8) * 2);
            o1[nt] = __builtin_amdgcn_mfma_f32_16x16x32_bf16(pa[ks], bv, o1[nt], 0, 0, 0);
            const bf16x8 bf = *(const LAS bf16x8*)(lR + e * 528 + (32 * ks + lq * 8) * 2);
            of[nt] = __builtin_amdgcn_mfma_f32_16x16x32_bf16(qa[ks], bf, of[nt], 0, 0, 0);
            const bf16x8 bb = *(const LAS bf16x8*)(lR + e * 528 + 256 + (32 * ks + lq * 8) * 2);
            ob[nt] = __builtin_amdgcn_mfma_f32_16x16x32_bf16(qa[ks], bb, ob[nt], 0, 0, 0); }
        __builtin_amdgcn_sched_barrier(0); }
    __syncthreads();
    {
        u32x4 rg[4];
#pragma unroll
        for (int i = 0; i < 4; ++i) { const int q = tid + i * 512, row = q >> 4, c16 = q & 15; rg[i] = *(const u32x4*)(SG + (size_t)row * 512 + c16 * 8); }
#pragma unroll
        for (int i = 0; i < 4; ++i) { const int q = tid + i * 512, row = q >> 4, c16 = q & 15; *(LAS u32x4*)(lK + row * 272 + c16 * 16) = rg[i]; }
    }
    __syncthreads();
#pragma unroll
    for (int r = 0; r < 4; ++r) { const int i = 16 * wid + lq * 4 + r;
        const float wqf = __expf(lgf * (float)(i + 1)), wqb = __expf(lgb * (float)(128 - i));
        float ov[8]; float ss = 0.f;
#pragma unroll
        for (int nt = 0; nt < 8; ++nt) { const float o = o1[nt][r] + wqf * of[nt][r] + wqb * ob[nt][r]; ov[nt] = o; ss += o * o; }
        ss += __shfl_xor(ss, 1); ss += __shfl_xor(ss, 2); ss += __shfl_xor(ss, 4); ss += __shfl_xor(ss, 8);
        const float rs = rsqrtf(ss * (1.0f / 128.0f) + 1e-6f);
#pragma unroll
        for (int nt = 0; nt < 8; ++nt) { const int e = 16 * nt + lr; const float g = bf2f(*(const LAS bf16_t*)(lK + i * 272 + e * 2));
            *(LAS bf16_t*)(lV + i * 272 + e * 2) = f2bf(ov[nt] * rs * g); }
        __builtin_amdgcn_sched_barrier(0); }
    __syncthreads();
    if (do_store) {
#pragma unroll
        for (int i = 0; i < 4; ++i) { const int q = tid + i * 512, row = q >> 4, c16 = q & 15;
            *(u32x4*)(Q + (size_t)row * 512 + c16 * 8) = *(const LAS u32x4*)(lV + row * 272 + c16 * 16); }
    }
    __syncthreads();
}

__device__ void yh_transpose_tile(const Params& p, int tile, LAS bf16_t* lt_) {
    const int ctile = tile & 7, ttile = tile >> 3;
    const int r0 = ttile * 256; int rb, L; row_info(r0, rb, L);
    const bf16_t* src = (const bf16_t*)(p.ws + OFF_CT) + (size_t)rb * 2048 + (size_t)(ctile * 64) * L + (r0 - rb);
    bf16_t* dst = (bf16_t*)(p.ws + OFF_KT) + (size_t)r0 * 512 + ctile * 64;
    const int tid = opaque_i(threadIdx.x);
    u32x4 w[4];
#pragma unroll
    for (int i = 0; i < 4; ++i) { const int q = tid + i * 512, a = q >> 5, b8 = (q & 31) * 8; w[i] = *(const u32x4*)(src + (size_t)a * L + b8); }
#pragma unroll
    for (int i = 0; i < 4; ++i) { const int q = tid + i * 512, a = q >> 5, b8 = (q & 31) * 8;
        lt_[(b8 + 0) * 66 + a] = (bf16_t)(w[i].x & 0xffffu); lt_[(b8 + 1) * 66 + a] = (bf16_t)(w[i].x >> 16);
        lt_[(b8 + 2) * 66 + a] = (bf16_t)(w[i].y & 0xffffu); lt_[(b8 + 3) * 66 + a] = (bf16_t)(w[i].y >> 16);
        lt_[(b8 + 4) * 66 + a] = (bf16_t)(w[i].z & 0xffffu); lt_[(b8 + 5) * 66 + a] = (bf16_t)(w[i].z >> 16);
        lt_[(b8 + 6) * 66 + a] = (bf16_t)(w[i].w & 0xffffu); lt_[(b8 + 7) * 66 + a] = (bf16_t)(w[i].w >> 16); }
    __syncthreads();
#pragma unroll
    for (int i = 0; i < 4; ++i) { const int q = tid + i * 512, a = q >> 3, b8 = (q & 7) * 8;
        u32x4 o;
        o.x = (unsigned)lt_[a * 66 + b8 + 0] | ((unsigned)lt_[a * 66 + b8 + 1] << 16); o.y = (unsigned)lt_[a * 66 + b8 + 2] | ((unsigned)lt_[a * 66 + b8 + 3] << 16);
        o.z = (unsigned)lt_[a * 66 + b8 + 4] | ((unsigned)lt_[a * 66 + b8 + 5] << 16); o.w = (unsigned)lt_[a * 66 + b8 + 6] | ((unsigned)lt_[a * 66 + b8 + 7] << 16);
        *(u32x4*)(dst + (size_t)a * 512 + b8) = o; }
    __syncthreads();
}

#define XB_TMO      128
#define XB_XCNT(j)  (256  + 64 * (j))
#define XB_XSUB(j)  (1280 + 64 * (j))
#define XB_XGEN(j)  (2304 + 64 * (j))
#define XB_TOP      3328
#define XB_TOPGEN   3392
#define XCD_BAR_WORDS 3456
#define XB_SPIN_CAP (1u << 18)

__device__ __forceinline__ unsigned xb_ld(unsigned* p)              { return __hip_atomic_load(p, __ATOMIC_RELAXED, __HIP_MEMORY_SCOPE_AGENT); }
__device__ __forceinline__ unsigned xb_add(unsigned* p, unsigned v) { return __hip_atomic_fetch_add(p, v, __ATOMIC_RELAXED, __HIP_MEMORY_SCOPE_AGENT); }
__device__ __forceinline__ unsigned xb_xcc_id() { return (unsigned)__builtin_amdgcn_s_getreg((3 << 11) | 20) & 0xFu; }
#define XB_SPIN(cond, bar) do { unsigned _sp = 0; while (cond) { __builtin_amdgcn_s_sleep(1); \
    if ((++_sp & 255u) == 0u) { if (xb_ld(&(bar)[XB_TMO])) break; if (_sp > XB_SPIN_CAP) { atomicAdd(&(bar)[XB_TMO], 1u); break; } } } } while (0)

struct XcdBarrier {
    unsigned* bar; unsigned x;
    volatile LAS unsigned* st;
};

__device__ __forceinline__ XcdBarrier xcd_barrier_post(unsigned* bar, volatile LAS unsigned* st) {
    XcdBarrier b; b.bar = bar; b.x = xb_xcc_id(); b.st = st;
    if (threadIdx.x == 0) (void)xb_add(&bar[XB_XCNT(b.x)], 1u);
    return b;
}
__device__ __forceinline__ void xcd_barrier_complete(unsigned* bar, unsigned x, unsigned& nloc, unsigned& nx) {
    const unsigned G = gridDim.x * gridDim.y * gridDim.z;
    unsigned sum, cnt, mine, sp = 0u;
    for (;;) {
        sum = 0u; cnt = 0u; mine = 0u;
#pragma unroll
        for (unsigned j = 0; j < 16; ++j) { const unsigned c = xb_ld(&bar[XB_XCNT(j)]); sum += c; cnt += (c > 0u) ? 1u : 0u; mine = (j == x) ? c : mine; }
        if (sum == G) break;
        __builtin_amdgcn_s_sleep(1);
        if ((++sp & 255u) == 0u) { if (xb_ld(&bar[XB_TMO])) break; if (sp > XB_SPIN_CAP) { atomicAdd(&bar[XB_TMO], 1u); break; } }
    }
    nloc = mine > 0u ? mine : 1u; nx = cnt > 0u ? cnt : 1u;
}

__device__ __forceinline__ void xcd_barrier(const XcdBarrier& b) {
    asm volatile("s_waitcnt vmcnt(0)" ::: "memory");
    __syncthreads();
    if (threadIdx.x == 0) {
        unsigned* bar = b.bar;
        __builtin_amdgcn_s_waitcnt(0);
        unsigned nloc = b.st[0], nx = b.st[1];
        if (nloc == 0u) { xcd_barrier_complete(bar, b.x, nloc, nx); b.st[0] = nloc; b.st[1] = nx; }
        const unsigned old = xb_add(&bar[XB_XSUB(b.x)], 1u);
        const unsigned gen = old / nloc;
        if (old + 1u == (gen + 1u) * nloc) {
            __builtin_amdgcn_fence(__ATOMIC_RELEASE, "agent");
            asm volatile("s_waitcnt vmcnt(0)" ::: "memory");
            const unsigned og = xb_add(&bar[XB_TOP], 1u);
            const unsigned tg = og / nx;
            if (og + 1u == (tg + 1u) * nx) xb_add(&bar[XB_TOPGEN], 1u);
            else XB_SPIN(xb_ld(&bar[XB_TOPGEN]) == tg, bar);
            __builtin_amdgcn_fence(__ATOMIC_ACQUIRE, "agent");
            xb_add(&bar[XB_XGEN(b.x)], 1u);
            asm volatile("s_waitcnt vmcnt(0)" ::: "memory");
        } else {
            XB_SPIN(xb_ld(&bar[XB_XGEN(b.x)]) == gen, bar);
            __builtin_amdgcn_fence(__ATOMIC_ACQUIRE, "agent");
            asm volatile("s_waitcnt vmcnt(0)" ::: "memory");
        }
    }
    __syncthreads();
}


__device__ __attribute__((noinline)) void xcd_barrier_call(unsigned* bar, unsigned x, volatile LAS unsigned* st) { XcdBarrier b; b.bar = bar; b.x = x; b.st = st; xcd_barrier(b); }

typedef FftCfg<32, 32, 16, 512> CfgBig;
typedef FftCfg<32, 16, 16, 256> CfgSmall;

#define PHASE_SYNC() do { if (ph_hi - ph_lo > 1) xcd_barrier_call(xb.bar, xb.x, xb.st); } while (0)
#ifndef HY_REP
#define HY_REP 1
#endif
#ifndef DUP_MASK
#define DUP_MASK 0
#endif
#ifndef PHASE_MASK
#define PHASE_MASK 0x1fff
#endif
#define RUN(ph) (((PHASE_MASK >> (ph)) & 1) && ph_lo <= (ph) && (ph) < ph_hi)

__global__ void __launch_bounds__(512, 2) hybrid_forward(Params p) {
    cg::grid_group grid = cg::this_grid();
    extern __shared__ __attribute__((aligned(16))) unsigned char smem[];
    LAS unsigned char* lds = (LAS unsigned char*)smem;
    const int ph_lo = p.ph_lo, ph_hi = p.ph_hi;
    const int tid = threadIdx.x;
    bf16_t* slotB = (bf16_t*)((char*)p.out + 2048);
    pg8::StaticOrder S;
    volatile LAS unsigned* xb_words = (volatile LAS unsigned*)(lds + SMEM_BYTES);
    if (tid < 4) xb_words[tid] = 0u;
    __syncthreads();
    XcdBarrier xb = xcd_barrier_post((unsigned*)(p.ws + OFF_BAR), xb_words);

    if (RUN(0)) { auto phf = [&]() {
        phase0_transposes(p, (LAS float*)lds);
        phase0_rot(p);
        for (int u = blockIdx.x; u < 192 * REP_FILT; u += gridDim.x) filter_unit(p, u % 192, lds);
        row_phase(p, 0, p.in[2], nullptr, REP_ROW0);
    }; phf(); if ((DUP_MASK >> 0) & 1) phf(); }
    if (ph_lo < 1 && ph_hi > 1) grid.sync();
    if (RUN(1)) { auto phf = [&]() {
        pg8::Gemm g{slotB, (const bf16_t*)(p.ws + OFF_WUP1), T_ALL, 5632, 1024, 2048, 1024, 1 << 30, 0l};
        S.init(g.M, g.N, gridDim.x, blockIdx.x);
        pg8::gemm_phase(lds, g, S, pg8::EpiSwiglu{(bf16_t*)(p.ws + OFF_G), 2816});
    }; phf(); if ((DUP_MASK >> 1) & 1) phf(); }
    if (ph_lo < 2 && ph_hi > 2) PHASE_SYNC();
    if (RUN(2)) { auto phf = [&]() {
        pg8::Gemm g{(const bf16_t*)(p.ws + OFF_G), (const bf16_t*)(p.ws + OFF_WDN1), T_ALL, 1024, 2816, 2816, 2816, 1 << 30, 0l};
        S.init(g.M, g.N, gridDim.x, blockIdx.x);
        pg8::gemm_phase(lds, g, S, pg8::EpiBf16{slotB, 2048});
    }; phf(); if ((DUP_MASK >> 2) & 1) phf(); }
    if (ph_lo < 3 && ph_hi > 3) { PHASE_SYNC();
#pragma unroll 1
        for (int rep = 0; rep < EXTRA_SYNCS; ++rep) xcd_barrier_call(xb.bar, xb.x, xb.st); }
    if (RUN(3)) { auto phf = [&]() { row_phase(p, 1, p.in[6], p.in[7]); }; phf(); if ((DUP_MASK >> 3) & 1) phf(); }
    if (ph_lo < 4 && ph_hi > 4) PHASE_SYNC();
    if (RUN(4)) { auto phf = [&]() {
        {
            pg8::Gemm g{(const bf16_t*)(p.ws + OFF_WIN), slotB, 2048, T_ALL, 1024, 1024, 2048, 1 << 30, 0l};
            S.init(g.M, g.N, gridDim.x, blockIdx.x);
            pg8::gemm_phase(lds, g, S, pg8::EpiCT{(bf16_t*)(p.ws + OFF_CT)});
        }
        {
            pg8::Gemm g{slotB, (const bf16_t*)(p.ws + OFF_WIN) + (size_t)2048 * 1024, T_ALL, 1536, 1024, 2048, 1024, 1 << 30, 0l};
            S.init(g.M, g.N, gridDim.x, (blockIdx.x + gridDim.x / 2) % gridDim.x);
            pg8::gemm_phase(lds, g, S, pg8::EpiQKG{(bf16_t*)(p.ws + OFF_Q), (bf16_t*)(p.ws + OFF_K), (bf16_t*)(p.ws + OFF_SG), (const v2f*)(p.ws + OFF_ROT)});
        }
    }; phf(); if ((DUP_MASK >> 4) & 1) phf(); }
    if (ph_lo < 5 && ph_hi > 5) PHASE_SYNC();
    if (RUN(5)) { auto phf = [&]() { ret_state_phase(p, lds, 1536 * REP5); }; phf(); if ((DUP_MASK >> 5) & 1) phf(); }
    if (ph_lo < 6 && ph_hi > 6) PHASE_SYNC();
    int rep6 = 0;
    if (RUN(6)) { auto phf = [&]() {
        if (rep6++ == 0) ret_scan(p);
        LAS v2f* buf = (LAS v2f*)lds; LAS float* red = (LAS float*)(lds + FFT_BYTES); LAS unsigned short* stg = (LAS unsigned short*)(lds + FFT_BYTES + 1024);
        unsigned* zscr = (unsigned*)(p.ws + WS_END) + (size_t)blockIdx.x * 16384;
        unsigned* kscr = (unsigned*)(p.ws + OFF_WUP1) + (size_t)blockIdx.x * 16384;
        for (int u = blockIdx.x; u < 512 * HY_REP; u += gridDim.x) hyena_channel<CfgBig>(p, buf, red, stg, kscr, zscr, tid, 1, u & 511, u >= 512 * (HY_REP - 1));
        for (int u = blockIdx.x; u < 256 * HY_REP; u += gridDim.x) { const int hb = tid >> 8; hyena_channel<CfgSmall>(p, buf + hb * CfgSmall::PHYS, red + hb * 32, stg + hb * 4096, kscr + hb * 8192, zscr + hb * 8192, tid & 255, 0, (u & 255) * 2 + hb, u >= 256 * (HY_REP - 1)); }
    }; phf(); if ((DUP_MASK >> 6) & 1) phf(); }
    if (ph_lo < 7 && ph_hi > 7) PHASE_SYNC();
    if (RUN(7)) { auto phf = [&]() { for (int u = blockIdx.x; u < 1536 * REP7; u += gridDim.x) ret_out_unit(p, u % 1536, lds, u >= 1536 * (REP7 - 1));
        for (int u = blockIdx.x; u < 1536; u += gridDim.x) yh_transpose_tile(p, u, (LAS bf16_t*)lds); }; phf(); if ((DUP_MASK >> 7) & 1) phf(); }
    if (ph_lo < 8 && ph_hi > 8) PHASE_SYNC();
    if (RUN(8)) { auto phf = [&]() {
        pg8::Gemm g{(const bf16_t*)(p.ws + OFF_KT), (const bf16_t*)(p.ws + OFF_WOUT), T_ALL, 1024, 1024, 512, 1024, 8, (long)OFF_Q - (long)OFF_KT - 8 * 128};
        S.init(g.M, g.N, gridDim.x, blockIdx.x);
        pg8::gemm_phase(lds, g, S, pg8::EpiBf16{slotB, 2048});
    }; phf(); if ((DUP_MASK >> 8) & 1) phf(); }
    if (ph_lo < 9 && ph_hi > 9) PHASE_SYNC();
    if (RUN(9)) { auto phf = [&]() { row_phase(p, 2, p.in[23], p.in[24]); }; phf(); if ((DUP_MASK >> 9) & 1) phf(); }
    if (ph_lo < 10 && ph_hi > 10) PHASE_SYNC();
    if (RUN(10)) { auto phf = [&]() {
        pg8::Gemm g{slotB, (const bf16_t*)(p.ws + OFF_WUP2), T_ALL, 5632, 1024, 2048, 1024, 1 << 30, 0l};
        S.init(g.M, g.N, gridDim.x, blockIdx.x);
        pg8::gemm_phase(lds, g, S, pg8::EpiSwiglu{(bf16_t*)(p.ws + OFF_G), 2816});
    }; phf(); if ((DUP_MASK >> 10) & 1) phf(); }
    if (ph_lo < 11 && ph_hi > 11) PHASE_SYNC();
    if (RUN(11)) { auto phf = [&]() {
        pg8::Gemm g{(const bf16_t*)(p.ws + OFF_G), (const bf16_t*)(p.ws + OFF_WDN2), T_ALL, 1024, 2816, 2816, 2816, 1 << 30, 0l};
        S.init(g.M, g.N, gridDim.x, blockIdx.x);
        pg8::gemm_phase(lds, g, S, pg8::EpiBf16{slotB, 2048});
    }; phf(); if ((DUP_MASK >> 11) & 1) phf(); }
    if (ph_lo < 12 && ph_hi > 12) PHASE_SYNC();
    if (RUN(12)) { auto phf = [&]() { row_phase(p, 3, p.in[28], nullptr); }; phf(); if ((DUP_MASK >> 12) & 1) phf(); }
}

#ifndef MULTI_LAUNCH
#define MULTI_LAUNCH 0
#endif
extern "C" void kernel_launch(void* const* d_in, const int* in_sizes, int n_in, void* d_out, int out_size, void* d_ws, size_t ws_size, hipStream_t stream) {
    static int grid_blocks = 0;
    if (!grid_blocks) {
        hipFuncSetAttribute((const void*)hybrid_forward, hipFuncAttributeMaxDynamicSharedMemorySize, SMEM_BYTES + 16);
        int dev = 0, cus = 0, per_cu = 0;
        hipGetDevice(&dev);
        hipDeviceGetAttribute(&cus, hipDeviceAttributeMultiprocessorCount, dev);
        hipOccupancyMaxActiveBlocksPerMultiprocessor(&per_cu, hybrid_forward, 512, SMEM_BYTES + 16);
        grid_blocks = cus * per_cu;
        if (grid_blocks <= 0 || grid_blocks > 256) grid_blocks = 256;
    }
    Params p{};
    for (int i = 0; i < 29; ++i) p.in[i] = (const float*)d_in[i];
    p.out = (float*)d_out; p.ws = (char*)d_ws;
#if MULTI_LAUNCH
    for (int ph = 0; ph < 13; ++ph) { p.ph_lo = ph; p.ph_hi = ph + 1; hipLaunchKernelGGL(hybrid_forward, dim3(256), dim3(512), 0, stream, p); }
#else
    p.ph_lo = 0; p.ph_hi = 13;
    hipMemsetAsync((char*)d_ws + OFF_BAR, 0, XCD_BAR_WORDS * 4, stream);
    void* args[] = {&p};
    hipError_t e = hipLaunchCooperativeKernel((void*)hybrid_forward, dim3(grid_blocks), dim3(512), args, SMEM_BYTES + 16, stream);
    if (e != hipSuccess) fprintf(stderr, "cooperative launch failed: %s\n", hipGetErrorString(e));
#endif
}
```
